# Optimizing an MI355X kernel written in HIP

```python
import math
import jax
import jax.numpy as jnp
from jax import lax
import numpy as np

D_MODEL = 1024
BATCH = 16
SEQ = 256
DEPTH = 2
DEC_BATCH = 2
DEC_SEQ = 2048
PAST_LEN = 256

GRID_W = 64
GROUP_W = D_MODEL // 4
HEAD_DIM = 64
DA_HEADS = GROUP_W // HEAD_DIM
DA_QK = HEAD_DIM // 2
DA_V = HEAD_DIM
MLA_HEADS = GROUP_W // HEAD_DIM
MLA_NOPE = HEAD_DIM
MLA_ROPE = HEAD_DIM // 2
MLA_V = HEAD_DIM
MLA_Q_LORA = GROUP_W
MLA_KV_LORA = GROUP_W // 2
NA_HEADS = GROUP_W // HEAD_DIM
NA_DIM = HEAD_DIM
NA_KR = 8
NA_KC = 16
CONV_CH = GROUP_W
CONV_W = 31
D_FF = 4 * D_MODEL
ROPE_BASE = 10000.0
QBLK = 128
EPS = 1e-6
N_MOD = 6

IN_SIZES = (2 * DA_HEADS * DA_QK, 2 * DA_HEADS * DA_QK, DA_HEADS * DA_V,
            MLA_Q_LORA, MLA_KV_LORA, MLA_ROPE,
            NA_HEADS * NA_DIM, NA_HEADS * NA_DIM, NA_HEADS * NA_DIM,
            2 * CONV_CH)
IN_COLS = sum(IN_SIZES)
IN_OFFSETS = tuple(int(o) for o in np.cumsum(IN_SIZES)[:-1])
MIX_OUT = DA_HEADS * DA_V + MLA_HEADS * MLA_V + NA_HEADS * NA_DIM + CONV_CH

kernel_name = 'hybrid_dit_prefix_ctx_step'


def rmsnorm(x, g):
    x32 = x.astype(jnp.float32)
    y = x32 * lax.rsqrt(jnp.mean(x32 * x32, axis=-1, keepdims=True) + EPS)
    return y.astype(x.dtype) * g


def layernorm(x, g, b):
    x32 = x.astype(jnp.float32)
    mu = jnp.mean(x32, axis=-1, keepdims=True)
    var = jnp.mean(jnp.square(x32 - mu), axis=-1, keepdims=True)
    return ((x32 - mu) * lax.rsqrt(var + EPS)).astype(x.dtype) * g + b


def heads(t, n):
    B, S, _ = t.shape
    return t.reshape(B, S, n, -1).transpose(0, 2, 1, 3)


def merge_heads(t):
    B, n, S, d = t.shape
    return t.transpose(0, 2, 1, 3).reshape(B, S, n * d)


def rope1d(x, pos):
    d = x.shape[-1]
    half = d // 2
    freqs = ROPE_BASE ** (-jnp.arange(half, dtype=jnp.float32) * 2.0 / d)
    ang = pos[:, None] * freqs[None, :]
    cos = jnp.cos(ang).astype(x.dtype)
    sin = jnp.sin(ang).astype(x.dtype)
    x1, x2 = x[..., :half], x[..., half:]
    return jnp.concatenate([x1 * cos - x2 * sin, x1 * sin + x2 * cos], axis=-1)


def rope2d(x, rows, cols):
    h = x.shape[-1] // 2
    return jnp.concatenate([rope1d(x[..., :h], rows), rope1d(x[..., h:], cols)], axis=-1)


def sweep_query_blocks(fn, qs):
    B, H, S = qs[0].shape[:3]
    blk = math.gcd(S, QBLK)
    nb = S // blk
    blocks = tuple(jnp.moveaxis(q.reshape(B, H, nb, blk, q.shape[-1]), 2, 0) for q in qs)
    out = lax.map(fn, blocks)
    return jnp.moveaxis(out, 0, 2).reshape(B, H, S, out.shape[-1])


def attn_core(q, k, v):
    scale = q.shape[-1] ** -0.5
    def blk(qb):
        s = jnp.einsum('bhqd,bhkd->bhqk', qb[0], k).astype(jnp.float32) * scale
        p = jax.nn.softmax(s, axis=-1).astype(v.dtype)
        return jnp.einsum('bhqk,bhkd->bhqd', p, v)
    return sweep_query_blocks(blk, (q,))


def diff_lambda(lq1, lk1, lq2, lk2, layer):
    lam_init = 0.8 - 0.6 * math.exp(-0.3 * layer)
    f = lambda a, b: jnp.exp(jnp.sum(a.astype(jnp.float32) * b.astype(jnp.float32)))
    return f(lq1, lk1) - f(lq2, lk2) + lam_init, lam_init


def diff_attn_core(q1, q2, k1, k2, v, lam):
    scale = DA_QK ** -0.5
    def blk(qb):
        a, b = qb
        s1 = jnp.einsum('bhqd,bhkd->bhqk', a, k1).astype(jnp.float32) * scale
        s2 = jnp.einsum('bhqd,bhkd->bhqk', b, k2).astype(jnp.float32) * scale
        p = jax.nn.softmax(s1, axis=-1) - lam * jax.nn.softmax(s2, axis=-1)
        return jnp.einsum('bhqk,bhkd->bhqd', p.astype(v.dtype), v)
    return sweep_query_blocks(blk, (q1, q2))


def neighbourhood_attn_latent(q, k, v, kc, vc, rpb):
    B, H, S, d = q.shape
    rows = S // GRID_W
    kr = min(NA_KR, rows)
    scale = d ** -0.5
    qg = q.reshape(B, H, rows, GRID_W, d)
    kg = k.reshape(B, H, rows, GRID_W, d)
    vg = v.reshape(B, H, rows, GRID_W, d)
    r = np.arange(rows)
    row_idx = np.clip(r - kr // 2, 0, rows - kr)[:, None] + np.arange(kr)[None, :]
    kb = jnp.take(kg, row_idx, axis=2)
    vb = jnp.take(vg, row_idx, axis=2)
    w = np.arange(GRID_W)
    col_start = np.clip(w - NA_KC // 2, 0, GRID_W - NA_KC)
    col_ok = (w[None, :] >= col_start[:, None]) & (w[None, :] < col_start[:, None] + NA_KC)
    dr = row_idx - r[:, None] + NA_KR - 1
    dc = np.clip(w[None, :] - w[:, None], -(NA_KC - 1), NA_KC - 1) + NA_KC - 1
    bias = rpb[:, dr[:, None, :, None], dc[None, :, None, :]]
    s_loc = jnp.einsum('bhrqd,bhrjwd->bhrqjw', qg, kb).astype(jnp.float32) * scale + bias.astype(jnp.float32)
    s_loc = jnp.where(col_ok[:, None, :], s_loc, -jnp.inf)
    n_loc = kr * GRID_W
    s_loc = s_loc.reshape(B, H, rows, GRID_W, n_loc)
    s_ctx = jnp.einsum('bhrqd,bhkd->bhrqk', qg, kc).astype(jnp.float32) * scale
    p = jax.nn.softmax(jnp.concatenate([s_loc, s_ctx], axis=-1), axis=-1).astype(v.dtype)
    p_loc = p[..., :n_loc].reshape(B, H, rows, GRID_W, kr, GRID_W)
    o = (jnp.einsum('bhrqjw,bhrjwd->bhrqd', p_loc, vb)
         + jnp.einsum('bhrqk,bhkd->bhrqd', p[..., n_loc:], vc))
    return o.reshape(B, H, S, d)


def conformer_conv(u, dw, db, ln_g, ln_b):
    a, b = jnp.split(u, 2, axis=-1)
    g = a * jax.nn.sigmoid(b)
    y = lax.conv_general_dilated(g, dw[:, None, :], window_strides=(1,),
                                 padding=[(CONV_W // 2, CONV_W // 2)],
                                 dimension_numbers=('NWC', 'WIO', 'NWC'),
                                 feature_group_count=CONV_CH) + db
    return jax.nn.silu(layernorm(y, ln_g, ln_b))


def token_mixers(h, lw, layer, ctx):
    B, S, _ = h.shape
    latent = ctx is not None
    (da_q, da_k, da_v, mla_qd, mla_kvd, mla_kr,
     na_q, na_k, na_v, conv_u) = jnp.split(h @ lw['w_in'], IN_OFFSETS, axis=-1)
    if latent:
        c_dak, c_dav, c_ckv, c_kr, c_nak, c_nav = ctx
        t = jnp.arange(S)
        rows = (t // GRID_W).astype(jnp.float32)
        cols = (t % GRID_W).astype(jnp.float32)
        rot = lambda z: rope2d(z, rows, cols)
    qa, ka, va = heads(da_q, DA_HEADS), heads(da_k, DA_HEADS), heads(da_v, DA_HEADS)
    q1, q2 = qa[..., :DA_QK], qa[..., DA_QK:]
    k1, k2 = ka[..., :DA_QK], ka[..., DA_QK:]
    if latent:
        q1, q2 = rot(q1), rot(q2)
        k1 = jnp.concatenate([rot(k1), c_dak[..., :DA_QK]], axis=2)
        k2 = jnp.concatenate([rot(k2), c_dak[..., DA_QK:]], axis=2)
        va_all = jnp.concatenate([va, c_dav], axis=2)
    else:
        va_all = va
    lam, lam_init = diff_lambda(lw['lq1'], lw['lk1'], lw['lq2'], lw['lk2'], layer)
    o_da = rmsnorm(diff_attn_core(q1, q2, k1, k2, va_all, lam), lw['g_da_subln']) * (1.0 - lam_init)
    qm = heads(rmsnorm(mla_qd, lw['g_mla_q']) @ lw['w_mla_qup'], MLA_HEADS)
    q_nope, q_rope = qm[..., :MLA_NOPE], qm[..., MLA_NOPE:]
    ckv = rmsnorm(mla_kvd, lw['g_mla_kv'])
    if latent:
        q_rope = rot(q_rope)
        ckv_all = jnp.concatenate([ckv, c_ckv], axis=1)
        kr_all = jnp.concatenate([rot(mla_kr), c_kr], axis=1)
    else:
        ckv_all, kr_all = ckv, mla_kr
    kvm = heads(ckv_all @ lw['w_mla_kvup'], MLA_HEADS)
    k_nope, v_m = kvm[..., :MLA_NOPE], kvm[..., MLA_NOPE:]
    Sk = ckv_all.shape[1]
    k_m = jnp.concatenate([k_nope, jnp.broadcast_to(kr_all[:, None], (B, MLA_HEADS, Sk, MLA_ROPE))], axis=-1)
    o_mla = attn_core(jnp.concatenate([q_nope, q_rope], axis=-1), k_m, v_m)
    qn, kn, vn = heads(na_q, NA_HEADS), heads(na_k, NA_HEADS), heads(na_v, NA_HEADS)
    if latent:
        o_na = neighbourhood_attn_latent(qn, kn, vn, c_nak, c_nav, lw['na_rpb'])
    else:
        o_na = attn_core(qn, kn, vn)
    o_conv = conformer_conv(conv_u, lw['conv_dw'], lw['conv_b'], lw['conv_ln_g'], lw['conv_ln_b'])
    mixed = jnp.concatenate([merge_heads(o_da), merge_heads(o_mla), merge_heads(o_na), o_conv], axis=-1) @ lw['w_out']
    new_ctx = None if latent else (ka, va, ckv, mla_kr, kn, vn)
    return mixed, new_ctx


def modulation(cvec, w_mod, b_mod):
    m = jax.nn.silu(cvec) @ w_mod + b_mod
    return jnp.split(m[:, None, :], N_MOD, axis=-1)


def trunk_layer(x, cvec, lw, layer, ctx):
    sh1, sc1, g1, sh2, sc2, g2 = modulation(cvec, lw['w_mod'], lw['b_mod'])
    h = rmsnorm(x, lw['g_mix']) * (1.0 + sc1) + sh1
    mixed, new_ctx = token_mixers(h, lw, layer, ctx)
    x = x + g1 * mixed
    h = rmsnorm(x, lw['g_ff']) * (1.0 + sc2) + sh2
    x = x + g2 * (jnp.square(jax.nn.relu(h @ lw['w_ff1'])) @ lw['w_ff2'])
    return x, new_ctx


def setup_inputs(seed: int = 0) -> dict:
    key = jax.random.key(seed)
    keys = jax.random.split(key, 40)
    it = iter(range(40))
    nrm = lambda shape, s: jax.random.normal(keys[next(it)], shape, jnp.float32) * s
    gain = lambda shape: 1.0 + nrm(shape, 0.02)
    L = DEPTH
    return {
        'x_prompt': nrm((BATCH, SEQ, D_MODEL), 1.0),
        'x_sample': nrm((DEC_BATCH, DEC_SEQ, D_MODEL), 1.0),
        'c': nrm((DEC_BATCH, D_MODEL), 1.0),
        'cache_da_k': nrm((DEC_BATCH, L, DA_HEADS, PAST_LEN, 2 * DA_QK), 1.0),
        'cache_da_v': nrm((DEC_BATCH, L, DA_HEADS, PAST_LEN, DA_V), 1.0),
        'cache_mla_ckv': nrm((DEC_BATCH, L, PAST_LEN, MLA_KV_LORA), 1.0),
        'cache_mla_krope': nrm((DEC_BATCH, L, PAST_LEN, MLA_ROPE), 1.0),
        'cache_na_k': nrm((DEC_BATCH, L, NA_HEADS, PAST_LEN, NA_DIM), 1.0),
        'cache_na_v': nrm((DEC_BATCH, L, NA_HEADS, PAST_LEN, NA_DIM), 1.0),
        'c_ctx': nrm((D_MODEL,), 1.0),
        'w_mod': nrm((L, D_MODEL, N_MOD * D_MODEL), 0.5 * D_MODEL ** -0.5),
        'b_mod': nrm((L, N_MOD * D_MODEL), 0.01),
        'g_norm_mix': gain((L, D_MODEL)),
        'g_norm_ff': gain((L, D_MODEL)),
        'w_in': nrm((L, D_MODEL, IN_COLS), D_MODEL ** -0.5),
        'da_lambda_q1': nrm((L, DA_QK), 0.1),
        'da_lambda_k1': nrm((L, DA_QK), 0.1),
        'da_lambda_q2': nrm((L, DA_QK), 0.1),
        'da_lambda_k2': nrm((L, DA_QK), 0.1),
        'g_da_subln': gain((L, DA_V)),
        'g_mla_q': gain((L, MLA_Q_LORA)),
        'w_mla_qup': nrm((L, MLA_Q_LORA, MLA_HEADS * (MLA_NOPE + MLA_ROPE)), MLA_Q_LORA ** -0.5),
        'g_mla_kv': gain((L, MLA_KV_LORA)),
        'w_mla_kvup': nrm((L, MLA_KV_LORA, MLA_HEADS * (MLA_NOPE + MLA_V)), MLA_KV_LORA ** -0.5),
        'na_rpb': nrm((L, NA_HEADS, 2 * NA_KR - 1, 2 * NA_KC - 1), 0.1),
        'conv_dw': nrm((L, CONV_W, CONV_CH), CONV_W ** -0.5),
        'conv_b': nrm((L, CONV_CH), 0.01),
        'conv_ln_g': gain((L, CONV_CH)),
        'conv_ln_b': nrm((L, CONV_CH), 0.01),
        'w_out': nrm((L, MIX_OUT, D_MODEL), MIX_OUT ** -0.5),
        'w_ff1': nrm((L, D_MODEL, D_FF), D_MODEL ** -0.5),
        'w_ff2': nrm((L, D_FF, D_MODEL), D_FF ** -0.5),
        'g_final': gain((D_MODEL,)),
    }


def reference(x_prompt, x_sample, c, cache_da_k, cache_da_v, cache_mla_ckv, cache_mla_krope,
              cache_na_k, cache_na_v, c_ctx, w_mod, b_mod, g_norm_mix, g_norm_ff, w_in,
              da_lambda_q1, da_lambda_k1, da_lambda_q2, da_lambda_k2, g_da_subln,
              g_mla_q, w_mla_qup, g_mla_kv, w_mla_kvup, na_rpb,
              conv_dw, conv_b, conv_ln_g, conv_ln_b, w_out, w_ff1, w_ff2, g_final):
    xp, xs = x_prompt, x_sample
    ctx_lists = ([], [], [], [], [], [])
    for l in range(DEPTH):
        lw = {'w_mod': w_mod[l], 'b_mod': b_mod[l], 'g_mix': g_norm_mix[l], 'g_ff': g_norm_ff[l],
              'w_in': w_in[l], 'lq1': da_lambda_q1[l], 'lk1': da_lambda_k1[l],
              'lq2': da_lambda_q2[l], 'lk2': da_lambda_k2[l], 'g_da_subln': g_da_subln[l],
              'g_mla_q': g_mla_q[l], 'w_mla_qup': w_mla_qup[l], 'g_mla_kv': g_mla_kv[l],
              'w_mla_kvup': w_mla_kvup[l], 'na_rpb': na_rpb[l], 'conv_dw': conv_dw[l],
              'conv_b': conv_b[l], 'conv_ln_g': conv_ln_g[l], 'conv_ln_b': conv_ln_b[l],
              'w_out': w_out[l], 'w_ff1': w_ff1[l], 'w_ff2': w_ff2[l]}
        xp, new_ctx = trunk_layer(xp, c_ctx[None, :], lw, l, None)
        for lst, t in zip(ctx_lists, new_ctx):
            lst.append(t)
        cached = (cache_da_k[:, l], cache_da_v[:, l], cache_mla_ckv[:, l], cache_mla_krope[:, l],
                  cache_na_k[:, l], cache_na_v[:, l])
        xs, _ = trunk_layer(xs, c, lw, l, cached)
    y_prompt = rmsnorm(xp, g_final)
    y_sample = rmsnorm(xs, g_final)
    new_da_k = jnp.stack(ctx_lists[0], axis=1)
    new_da_v = jnp.stack(ctx_lists[1], axis=1)
    new_mla_ckv = jnp.stack(ctx_lists[2], axis=1)
    new_mla_krope = jnp.stack(ctx_lists[3], axis=1)
    new_na_k = jnp.stack(ctx_lists[4], axis=1)
    new_na_v = jnp.stack(ctx_lists[5], axis=1)
    return (y_prompt, y_sample, new_da_k, new_da_v, new_mla_ckv, new_mla_krope, new_na_k, new_na_v)
```

```cpp
#include <hip/hip_runtime.h>
#include <cstdint>
#include <cstdio>

typedef unsigned short bf16_t;
typedef short bf16x8 __attribute__((ext_vector_type(8)));
typedef float f32x4 __attribute__((ext_vector_type(4)));
typedef unsigned u32x2 __attribute__((ext_vector_type(2)));
typedef unsigned u32x4 __attribute__((ext_vector_type(4)));
#define LAS __attribute__((address_space(3)))
#define DI __device__ __forceinline__

constexpr int DM = 1024, NTOK = 8192, NCTXTOK = 4096, NLAYER = 2;
constexpr int NIN = 2560;
constexpr int DFF = 4096;
constexpr float EPS = 1e-6f;
enum { I_XP = 0, I_XS, I_C, I_CDAK, I_CDAV, I_CCKV, I_CKR, I_CNAK, I_CNAV, I_CCTX, I_WMOD, I_BMOD, I_GMIX, I_GFF, I_WIN,
       I_LQ1, I_LK1, I_LQ2, I_LK2, I_GSUB, I_GMQ, I_WQUP, I_GMKV, I_WKVUP, I_RPB, I_CDW, I_CB, I_CLG, I_CLB, I_WOUT, I_WFF1, I_WFF2, I_GFIN, N_IN };
constexpr size_t O_YP = 0, O_YS = 4194304, O_DAK = 8388608, O_DAV = 10485760, O_CKV = 12582912, O_KR = 13631488, O_NAK = 13893632, O_NAV = 15990784;

constexpr size_t al256(size_t x) { return (x + 255) & ~(size_t)255; }
constexpr size_t WS_BAR   = 0;
constexpr size_t WS_WTIN  = 16384;
constexpr size_t WS_WTQUP = WS_WTIN  + (size_t)NLAYER * NIN * 1024 * 2;
constexpr size_t WS_WTKV  = WS_WTQUP + (size_t)NLAYER * 384 * 256 * 2;
constexpr size_t WS_WTOUT = WS_WTKV  + (size_t)NLAYER * 512 * 128 * 2;
constexpr size_t WS_WTFF1 = WS_WTOUT + (size_t)NLAYER * 1024 * 1024 * 2;
constexpr size_t WS_WTFF2 = WS_WTFF1 + (size_t)NLAYER * 4096 * 1024 * 2;
constexpr size_t WS_MOD   = WS_WTFF2 + (size_t)NLAYER * 1024 * 4096 * 2;
constexpr size_t WS_ROPE  = WS_MOD   + (size_t)NLAYER * 3 * 6144 * 4;
constexpr size_t WS_H     = WS_ROPE  + 4096;
constexpr size_t WS_QDA   = WS_H     + (size_t)NTOK * 1024 * 2;
constexpr size_t WS_KDA   = WS_QDA   + (size_t)NTOK * 256 * 2;
constexpr size_t WS_VDA   = WS_KDA   + (size_t)NTOK * 256 * 2;
constexpr size_t WS_QNA   = WS_VDA   + (size_t)NTOK * 256 * 2;
constexpr size_t WS_KNA   = WS_QNA   + (size_t)NTOK * 256 * 2;
constexpr size_t WS_VNA   = WS_KNA   + (size_t)NTOK * 256 * 2;
constexpr size_t WS_QD    = WS_VNA   + (size_t)NTOK * 256 * 2;
constexpr size_t WS_SSQQ  = WS_QD    + (size_t)NTOK * 256 * 2;
constexpr size_t WS_CKVA  = WS_SSQQ  + (size_t)NTOK * 4 * 4;
constexpr size_t WS_KRA   = WS_CKVA  + (size_t)NLAYER * 8704 * 128 * 2;
constexpr size_t WS_KRC   = WS_KRA   + (size_t)NTOK * 32 * 2;
constexpr size_t WS_QM    = WS_KRC   + (size_t)NLAYER * 2 * 256 * 32 * 2;
constexpr size_t WS_KVM   = WS_QM    + (size_t)NTOK * 384 * 2;
constexpr size_t WS_KCDA  = WS_KVM   + (size_t)8704 * 512 * 2;
constexpr size_t WS_VCDA  = WS_KCDA  + (size_t)NLAYER * 2 * 4 * 256 * 64 * 2;
constexpr size_t WS_KCNA  = WS_VCDA  + (size_t)NLAYER * 2 * 4 * 256 * 64 * 2;
constexpr size_t WS_VCNA  = WS_KCNA  + (size_t)NLAYER * 2 * 4 * 256 * 64 * 2;
constexpr size_t WS_CU    = WS_VCNA  + (size_t)NLAYER * 2 * 4 * 256 * 64 * 2;
constexpr size_t WS_MIX   = WS_CU    + (size_t)NTOK * 512 * 2;
constexpr size_t WS_XRES  = WS_MIX   + (size_t)NTOK * 1024 * 2;
constexpr size_t WS_HBUF  = WS_XRES  + (size_t)NTOK * 1024 * 4;
constexpr size_t WS_END   = WS_HBUF  + (size_t)NTOK * 4096 * 2;

struct Params {
    const float* in[N_IN];
    float* out;
    unsigned char* ws;
};

constexpr int LDS_BYTES = 65536;

typedef float f32x2 __attribute__((ext_vector_type(2)));
typedef __bf16 bf16x2v __attribute__((ext_vector_type(2)));
DI unsigned cvt_pk_bf16(float lo, float hi) { f32x2 v = {lo, hi}; return __builtin_bit_cast(unsigned, __builtin_convertvector(v, bf16x2v)); }
DI bf16_t f2bf(float x) { unsigned u = __float_as_uint(x); u += 0x7fffu + ((u >> 16) & 1u); return (bf16_t)(u >> 16); }
DI float bf2f(bf16_t v) { return __uint_as_float(((unsigned)v) << 16); }
DI float wave_sum(float v) {
#pragma unroll
    for (int o = 32; o > 0; o >>= 1) v += __shfl_xor(v, o);
    return v;
}
DI int seg_of_row(int row) { return row < 4096 ? 0 : (row < 6144 ? 1 : 2); }
DI const float* x_in_row(const Params& p, int row) { return row < 4096 ? p.in[I_XP] + (size_t)row * 1024 : p.in[I_XS] + (size_t)(row - 4096) * 1024; }

DI void gemm_stage(const bf16_t* __restrict__ A, const bf16_t* __restrict__ Bt, int K, int row0, int col0, int k0, LAS unsigned char* lds_stage, int tid) {
#pragma unroll
    for (int i = 0; i < 4; ++i) {
        const int b = i * 4096 + tid * 16, row = b >> 7, pch = (b >> 4) & 7, lch = pch ^ ((row >> 1) & 7);
        const bf16_t* ga = A + (size_t)(row0 + row) * K + k0 + lch * 8;
        const bf16_t* gb = Bt + (size_t)(col0 + row) * K + k0 + lch * 8;
        __builtin_amdgcn_global_load_lds((const unsigned*)ga, (LAS unsigned*)(lds_stage + b), 16, 0, 0);
        __builtin_amdgcn_global_load_lds((const unsigned*)gb, (LAS unsigned*)(lds_stage + 16384 + b), 16, 0, 0);
    }
}

DI void gemm_tile(const bf16_t* __restrict__ A, const bf16_t* __restrict__ Bt, int K, int row0, int col0, LAS unsigned char* lds, f32x4 (&acc)[4][4]) {
    const int tid = threadIdx.x, wid = tid >> 6, lane = tid & 63, wr = wid >> 1, wc = wid & 1, fr = lane & 15, fq = lane >> 4;
#pragma unroll
    for (int m = 0; m < 4; ++m)
#pragma unroll
        for (int n = 0; n < 4; ++n) acc[m][n] = (f32x4){0.f, 0.f, 0.f, 0.f};
    const int sw = (fr >> 1) & 7;
    const int offk0 = ((0 + fq) ^ sw) << 4, offk1 = ((4 + fq) ^ sw) << 4;
    const int abase = (wr * 64 + fr) * 128, bbase = 16384 + (wc * 64 + fr) * 128;
    const int nt = K >> 6;
    __syncthreads();
    gemm_stage(A, Bt, K, row0, col0, 0, lds, tid);
    for (int t = 0; t < nt; ++t) {
        asm volatile("s_waitcnt vmcnt(0)" ::: "memory");
        __syncthreads();
        if (t + 1 < nt) gemm_stage(A, Bt, K, row0, col0, (t + 1) << 6, lds + ((t + 1) & 1) * 32768, tid);
        LAS const unsigned char* st = lds + (t & 1) * 32768;
        bf16x8 af[4][2], bfr[4][2];
#pragma unroll
        for (int m = 0; m < 4; ++m) {
            af[m][0] = *(LAS const bf16x8*)(st + abase + m * 2048 + offk0);
            af[m][1] = *(LAS const bf16x8*)(st + abase + m * 2048 + offk1);
        }
#pragma unroll
        for (int n = 0; n < 4; ++n) {
            bfr[n][0] = *(LAS const bf16x8*)(st + bbase + n * 2048 + offk0);
            bfr[n][1] = *(LAS const bf16x8*)(st + bbase + n * 2048 + offk1);
        }
#pragma unroll
        for (int k = 0; k < 2; ++k)
#pragma unroll
            for (int m = 0; m < 4; ++m)
#pragma unroll
                for (int n = 0; n < 4; ++n)
                    acc[m][n] = __builtin_amdgcn_mfma_f32_16x16x32_bf16(bfr[n][k], af[m][k], acc[m][n], 0, 0, 0);
    }
}

DI f32x4 rope4(f32x4 v, const float* __restrict__ ropetab, int pos, int fq) {
    const f32x4 cs = *(const f32x4*)(ropetab + pos * 8 + 4 * (fq & 1));
    const f32x4 sn = *(const f32x4*)(ropetab + 512 + pos * 8 + 4 * (fq & 1));
    f32x4 o;
#pragma unroll
    for (int j = 0; j < 4; ++j) {
        const float pr = __shfl_xor(v[j], 32);
        o[j] = (fq >= 2) ? (pr * sn[j] + v[j] * cs[j]) : (v[j] * cs[j] - pr * sn[j]);
    }
    return o;
}
DI void store_bf16x4(bf16_t* dst, f32x4 v) { u32x2 w; w.x = cvt_pk_bf16(v[0], v[1]); w.y = cvt_pk_bf16(v[2], v[3]); *(u32x2*)dst = w; }

DI void epi_inproj(const Params& p, int l, f32x4 (&acc)[4][4], int tm, int tn, LAS unsigned char* lds) {
    const int tid = threadIdx.x, wid = tid >> 6, lane = tid & 63, wr = wid >> 1, wc = wid & 1, fr = lane & 15, fq = lane >> 4;
    unsigned char* ws = p.ws;
    const bool lat = tm >= 32;
    const float* ropetab = (const float*)(ws + WS_ROPE);
    float* out = p.out;
    if (tn == 8) {
        LAS float* ex = (LAS float*)lds;
        __syncthreads();
#pragma unroll
        for (int m = 0; m < 4; ++m) {
            float s = 0.f;
#pragma unroll
            for (int n = 0; n < 4; ++n)
#pragma unroll
                for (int j = 0; j < 4; ++j) s += acc[m][n][j] * acc[m][n][j];
            s += __shfl_xor(s, 16); s += __shfl_xor(s, 32);
            if (fq == 0) ex[(wr * 64 + m * 16 + fr) * 2 + wc] = s;
        }
        __syncthreads();
        const float* gkv = p.in[I_GMKV] + l * 128;
        bf16_t* ckva = (bf16_t*)(ws + WS_CKVA) + (size_t)l * 8704 * 128;
#pragma unroll
        for (int m = 0; m < 4; ++m) {
            const int rl = wr * 64 + m * 16 + fr, row = tm * 128 + rl;
            const float rstd = rsqrtf((ex[rl * 2] + ex[rl * 2 + 1]) * (1.0f / 128.0f) + EPS);
#pragma unroll
            for (int n = 0; n < 4; ++n) {
                const int col = wc * 64 + n * 16 + 4 * fq;
                const f32x4 g = *(const f32x4*)(gkv + col);
                f32x4 v = acc[m][n] * rstd * g;
                store_bf16x4(ckva + (size_t)row * 128 + col, v);
                if (!lat) { const int b = row >> 8, s = row & 255; *(f32x4*)(out + O_CKV + ((size_t)(b * 2 + l) * 256 + s) * 128 + col) = v; }
            }
        }
        __syncthreads();
        return;
    }
#pragma unroll
    for (int m = 0; m < 4; ++m) {
        const int row = tm * 128 + wr * 64 + m * 16 + fr;
        const int sl = (row - 4096) & 2047, prow = sl >> 6, pcol = sl & 63;
        const int cb = row >> 8, cs = row & 255;
        if (tn == 6 || tn == 7) {
            float s = 0.f;
#pragma unroll
            for (int n = 0; n < 4; ++n)
#pragma unroll
                for (int j = 0; j < 4; ++j) s += acc[m][n][j] * acc[m][n][j];
            s += __shfl_xor(s, 16); s += __shfl_xor(s, 32);
            if (fq == 0) ((float*)(ws + WS_SSQQ))[row * 4 + (tn - 6) * 2 + wc] = s;
        }
#pragma unroll
        for (int n = 0; n < 4; ++n) {
            const int cw = wc * 64 + n * 16 + 4 * fq;
            f32x4 v = acc[m][n];
            if (tn < 2) {
                if (lat) v = rope4(v, ropetab, (n & 1) ? pcol : prow, fq);
                store_bf16x4((bf16_t*)(ws + WS_QDA) + (size_t)row * 256 + tn * 128 + cw, v);
            } else if (tn < 4) {
                if (lat) v = rope4(v, ropetab, (n & 1) ? pcol : prow, fq);
                const int c = (tn - 2) * 128 + cw;
                store_bf16x4((bf16_t*)(ws + WS_KDA) + (size_t)row * 256 + c, v);
                if (!lat) *(f32x4*)(out + O_DAK + (((size_t)(cb * 2 + l) * 4 + (c >> 6)) * 256 + cs) * 64 + (c & 63)) = v;
            } else if (tn < 6) {
                const int c = (tn - 4) * 128 + cw;
                store_bf16x4((bf16_t*)(ws + WS_VDA) + (size_t)row * 256 + c, v);
                if (!lat) *(f32x4*)(out + O_DAV + (((size_t)(cb * 2 + l) * 4 + (c >> 6)) * 256 + cs) * 64 + (c & 63)) = v;
            } else if (tn < 8) {
                store_bf16x4((bf16_t*)(ws + WS_QD) + (size_t)row * 256 + (tn - 6) * 128 + cw, v);
            } else if (tn < 11) {
                store_bf16x4((bf16_t*)(ws + WS_QNA) + (size_t)row * 256 + (tn - 9) * 128 + cw, v);
            } else if (tn < 13) {
                const int c = (tn - 11) * 128 + cw;
                store_bf16x4((bf16_t*)(ws + WS_KNA) + (size_t)row * 256 + c, v);
                if (!lat) *(f32x4*)(out + O_NAK + (((size_t)(cb * 2 + l) * 4 + (c >> 6)) * 256 + cs) * 64 + (c & 63)) = v;
            } else if (tn < 15) {
                const int c = (tn - 13) * 128 + cw;
                store_bf16x4((bf16_t*)(ws + WS_VNA) + (size_t)row * 256 + c, v);
                if (!lat) *(f32x4*)(out + O_NAV + (((size_t)(cb * 2 + l) * 4 + (c >> 6)) * 256 + cs) * 64 + (c & 63)) = v;
            } else if (tn < 19) {
                store_bf16x4((bf16_t*)(ws + WS_CU) + (size_t)row * 512 + (tn - 15) * 128 + cw, v);
            } else {
                if (lat) v = rope4(v, ropetab, (n & 1) ? pcol : prow, fq);
                if (wc == 0 && n < 2) {
                    store_bf16x4((bf16_t*)(ws + WS_KRA) + (size_t)row * 32 + cw, v);
                    if (!lat) *(f32x4*)(out + O_KR + ((size_t)(cb * 2 + l) * 256 + cs) * 32 + cw) = v;
                }
            }
        }
    }
}

DI void epi_qup(const Params& p, f32x4 (&acc)[4][4], int tm, int tn) {
    const int tid = threadIdx.x, wid = tid >> 6, lane = tid & 63, wr = wid >> 1, wc = wid & 1, fr = lane & 15, fq = lane >> 4;
    unsigned char* ws = p.ws;
    const bool lat = tm >= 32;
    const float* ropetab = (const float*)(ws + WS_ROPE);
#pragma unroll
    for (int m = 0; m < 4; ++m) {
        const int row = tm * 128 + wr * 64 + m * 16 + fr;
        const int sl = (row - 4096) & 2047, prow = sl >> 6, pcol = sl & 63;
        const f32x4 sq = *(const f32x4*)((const float*)(ws + WS_SSQQ) + row * 4);
        const float rstd = rsqrtf((sq[0] + sq[1] + sq[2] + sq[3]) * (1.0f / 256.0f) + EPS);
#pragma unroll
        for (int n = 0; n < 4; ++n) {
            f32x4 v = acc[m][n] * rstd;
            if (tn == 2 && lat) v = rope4(v, ropetab, (n & 1) ? pcol : prow, fq);
            store_bf16x4((bf16_t*)(ws + WS_QM) + (size_t)row * 384 + tn * 128 + wc * 64 + n * 16 + 4 * fq, v);
        }
    }
}
DI void epi_kvup(const Params& p, f32x4 (&acc)[4][4], int tm, int tn) {
    const int tid = threadIdx.x, wid = tid >> 6, lane = tid & 63, wr = wid >> 1, wc = wid & 1, fr = lane & 15, fq = lane >> 4;
#pragma unroll
    for (int m = 0; m < 4; ++m) {
        const int row = tm * 128 + wr * 64 + m * 16 + fr;
#pragma unroll
        for (int n = 0; n < 4; ++n) store_bf16x4((bf16_t*)(p.ws + WS_KVM) + (size_t)row * 512 + tn * 128 + wc * 64 + n * 16 + 4 * fq, acc[m][n]);
    }
}
DI void epi_resid(const Params& p, int l, f32x4 (&acc)[4][4], int tm, int tn, int gi, bool from_input) {
    const int tid = threadIdx.x, wid = tid >> 6, lane = tid & 63, wr = wid >> 1, wc = wid & 1, fr = lane & 15, fq = lane >> 4;
    float* xres = (float*)(p.ws + WS_XRES);
    const int seg = seg_of_row(tm * 128);
    const float* gate = (const float*)(p.ws + WS_MOD) + ((size_t)l * 3 + seg) * 6144 + gi * 1024;
#pragma unroll
    for (int m = 0; m < 4; ++m) {
        const int row = tm * 128 + wr * 64 + m * 16 + fr;
        const float* src = from_input ? x_in_row(p, row) : xres + (size_t)row * 1024;
#pragma unroll
        for (int n = 0; n < 4; ++n) {
            const int col = tn * 128 + wc * 64 + n * 16 + 4 * fq;
            const f32x4 g = *(const f32x4*)(gate + col);
            const f32x4 xv = *(const f32x4*)(src + col);
            *(f32x4*)(xres + (size_t)row * 1024 + col) = xv + g * acc[m][n];
        }
    }
}
DI void epi_ff1(const Params& p, f32x4 (&acc)[4][4], int tm, int tn) {
    const int tid = threadIdx.x, wid = tid >> 6, lane = tid & 63, wr = wid >> 1, wc = wid & 1, fr = lane & 15, fq = lane >> 4;
#pragma unroll
    for (int m = 0; m < 4; ++m) {
        const int row = tm * 128 + wr * 64 + m * 16 + fr;
#pragma unroll
        for (int n = 0; n < 4; ++n) {
            f32x4 v = acc[m][n];
#pragma unroll
            for (int j = 0; j < 4; ++j) { const float r = fmaxf(v[j], 0.f); v[j] = r * r; }
            store_bf16x4((bf16_t*)(p.ws + WS_HBUF) + (size_t)row * 4096 + tn * 128 + wc * 64 + n * 16 + 4 * fq, v);
        }
    }
}

DI void transpose_tile(const float* __restrict__ src, int ld_src, bf16_t* __restrict__ dst, int K, int k0, int n0, int mode, const float* __restrict__ kscale, LAS float* t) {
    const int tid = threadIdx.x, ty = tid >> 4, tx = tid & 15;
    const int nd = n0 + 4 * tx;
    int sc;
    if (mode == 0) {
        if (nd < 1152) sc = nd; else if (nd < 2432) sc = nd + 32; else if (nd < 2464) sc = nd - 2432 + 1152; else sc = -1;
    } else if (mode == 1) {
        if (nd < 256) sc = (nd >> 6) * 96 + (nd & 63); else { const int r = nd - 256; sc = (r >> 5) * 96 + 64 + (r & 31); }
    } else sc = nd;
    __syncthreads();
#pragma unroll
    for (int i = 0; i < 4; ++i) {
        const int kk = ty + 16 * i;
        f32x4 v = (f32x4){0.f, 0.f, 0.f, 0.f};
        if (sc >= 0) v = *(const f32x4*)(src + (size_t)(k0 + kk) * ld_src + sc);
        if (kscale) v = v * kscale[k0 + kk];
        t[kk * 65 + 4 * tx + 0] = v[0]; t[kk * 65 + 4 * tx + 1] = v[1]; t[kk * 65 + 4 * tx + 2] = v[2]; t[kk * 65 + 4 * tx + 3] = v[3];
    }
    __syncthreads();
    const int nn = tid >> 2, kc = tid & 3;
    unsigned w[8];
#pragma unroll
    for (int e = 0; e < 8; ++e) w[e] = cvt_pk_bf16(t[(kc * 16 + 2 * e) * 65 + nn], t[(kc * 16 + 2 * e + 1) * 65 + nn]);
    bf16_t* d = dst + (size_t)(n0 + nn) * K + k0 + kc * 16;
    *(u32x4*)d = (u32x4){w[0], w[1], w[2], w[3]};
    *(u32x4*)(d + 8) = (u32x4){w[4], w[5], w[6], w[7]};
}

constexpr int TR_PER_LAYER = 640 + 24 + 16 + 256 + 1024 + 1024;
constexpr int N_TR = NLAYER * TR_PER_LAYER;
constexpr int N_MODU = NLAYER * 48 * 2;
constexpr int N_CACHE_ELEMS = NLAYER * 2 * (4 * 256 * 64 * 4 + 256 * 128 + 256 * 32);
constexpr int N_CACHEU = (N_CACHE_ELEMS / 4 + 255) / 256;

DI void prologue_unit(const Params& p, int u, LAS unsigned char* lds) {
    unsigned char* ws = p.ws;
    const int tid = threadIdx.x;
    if (u < N_TR) {
        const int l = u / TR_PER_LAYER; int r = u % TR_PER_LAYER;
        LAS float* t = (LAS float*)lds;
        if (r < 640) { transpose_tile(p.in[I_WIN] + (size_t)l * 1024 * 2464, 2464, (bf16_t*)(ws + WS_WTIN) + (size_t)l * NIN * 1024, 1024, (r / 40) * 64, (r % 40) * 64, 0, nullptr, t); return; }
        r -= 640;
        if (r < 24) { transpose_tile(p.in[I_WQUP] + (size_t)l * 256 * 384, 384, (bf16_t*)(ws + WS_WTQUP) + (size_t)l * 384 * 256, 256, (r / 6) * 64, (r % 6) * 64, 1, p.in[I_GMQ] + l * 256, t); return; }
        r -= 24;
        if (r < 16) { transpose_tile(p.in[I_WKVUP] + (size_t)l * 128 * 512, 512, (bf16_t*)(ws + WS_WTKV) + (size_t)l * 512 * 128, 128, (r / 8) * 64, (r % 8) * 64, 2, nullptr, t); return; }
        r -= 16;
        if (r < 256) { transpose_tile(p.in[I_WOUT] + (size_t)l * 1024 * 1024, 1024, (bf16_t*)(ws + WS_WTOUT) + (size_t)l * 1024 * 1024, 1024, (r / 16) * 64, (r % 16) * 64, 2, nullptr, t); return; }
        r -= 256;
        if (r < 1024) { transpose_tile(p.in[I_WFF1] + (size_t)l * 1024 * 4096, 4096, (bf16_t*)(ws + WS_WTFF1) + (size_t)l * 4096 * 1024, 1024, (r / 64) * 64, (r % 64) * 64, 2, nullptr, t); return; }
        r -= 1024;
        transpose_tile(p.in[I_WFF2] + (size_t)l * 4096 * 1024, 1024, (bf16_t*)(ws + WS_WTFF2) + (size_t)l * 1024 * 4096, 4096, (r / 16) * 64, (r % 16) * 64, 2, nullptr, t);
        return;
    }
    u -= N_TR;
    if (u < N_MODU) {
        const int l = u / 96, cchunk = u % 96;
        const int cg = tid & 15, ks = tid >> 4;
        const int col = cchunk * 64 + cg * 4;
        const float* wm = p.in[I_WMOD] + (size_t)l * 1024 * 6144;
        f32x4 a0 = (f32x4){0.f, 0.f, 0.f, 0.f}, a1 = a0, a2 = a0;
        for (int k = ks * 64; k < ks * 64 + 64; ++k) {
            const f32x4 w = *(const f32x4*)(wm + (size_t)k * 6144 + col);
            float c0 = p.in[I_CCTX][k], c1 = p.in[I_C][k], c2 = p.in[I_C][1024 + k];
            c0 = c0 / (1.f + __expf(-c0)); c1 = c1 / (1.f + __expf(-c1)); c2 = c2 / (1.f + __expf(-c2));
            a0 += w * c0; a1 += w * c1; a2 += w * c2;
        }
        LAS float* red = (LAS float*)lds;
        __syncthreads();
#pragma unroll
        for (int j = 0; j < 4; ++j) { red[(ks * 16 + cg) * 12 + j] = a0[j]; red[(ks * 16 + cg) * 12 + 4 + j] = a1[j]; red[(ks * 16 + cg) * 12 + 8 + j] = a2[j]; }
        __syncthreads();
        if (tid < 192) {
            const int cgi = tid / 12, e = tid % 12;
            float s = 0.f;
#pragma unroll
            for (int k2 = 0; k2 < 16; ++k2) s += red[(k2 * 16 + cgi) * 12 + e];
            const int seg = e >> 2, c = cchunk * 64 + cgi * 4 + (e & 3);
            ((float*)(ws + WS_MOD))[((size_t)l * 3 + seg) * 6144 + c] = s + p.in[I_BMOD][(size_t)l * 6144 + c];
        }
        __syncthreads();
        return;
    }
    u -= N_MODU;
    if (u < N_CACHEU) {
        const int e4 = (u * 256 + tid) * 4;
        if (e4 >= N_CACHE_ELEMS) return;
        constexpr int PER_LB = 4 * 256 * 64 * 4 + 256 * 128 + 256 * 32;
        const int lb = e4 / PER_LB, r = e4 % PER_LB, l = lb >> 1, b = lb & 1;
        const float* src; bf16_t* dst;
        if (r < 4 * 65536) {
            const int which = r >> 16, off = r & 65535;
            const int ii = which == 0 ? I_CDAK : which == 1 ? I_CDAV : which == 2 ? I_CNAK : I_CNAV;
            const size_t wo = which == 0 ? WS_KCDA : which == 1 ? WS_VCDA : which == 2 ? WS_KCNA : WS_VCNA;
            src = p.in[ii] + ((size_t)(b * 2 + l)) * 65536 + off;
            dst = (bf16_t*)(ws + wo) + ((size_t)(l * 2 + b)) * 65536 + off;
        } else if (r < 4 * 65536 + 32768) {
            const int off = r - 4 * 65536;
            src = p.in[I_CCKV] + ((size_t)(b * 2 + l)) * 32768 + off;
            dst = (bf16_t*)(ws + WS_CKVA) + ((size_t)l * 8704 + 8192 + b * 256) * 128 + off;
        } else {
            const int off = r - 4 * 65536 - 32768;
            src = p.in[I_CKR] + ((size_t)(b * 2 + l)) * 8192 + off;
            dst = (bf16_t*)(ws + WS_KRC) + ((size_t)(l * 2 + b)) * 8192 + off;
        }
        const f32x4 v = *(const f32x4*)src;
        store_bf16x4(dst, v);
        return;
    }
    u -= N_CACHEU;
    for (int e = tid; e < 512; e += 256) {
        const int pos = e >> 3, i = e & 7;
        const float freq = powf(10000.0f, -(float)i / 8.0f);
        const float ang = (float)pos * freq;
        ((float*)(ws + WS_ROPE))[e] = cosf(ang);
        ((float*)(ws + WS_ROPE))[512 + e] = sinf(ang);
    }
}
constexpr int N_PRO_UNITS = N_TR + N_MODU + N_CACHEU + 1;

DI void norm_rows(const Params& p, int l, int which, int unit, bool from_input) {
    const int tid = threadIdx.x, wid = tid >> 6, lane = tid & 63;
    const int row = unit * 4 + wid;
    const float* x = from_input ? x_in_row(p, row) : (const float*)(p.ws + WS_XRES) + (size_t)row * 1024;
    const int seg = seg_of_row(row);
    const float* mod = (const float*)(p.ws + WS_MOD) + ((size_t)l * 3 + seg) * 6144;
    const float* sh = mod + (which ? 3 : 0) * 1024, *sc = mod + (which ? 4 : 1) * 1024;
    const float* g = p.in[which ? I_GFF : I_GMIX] + l * 1024;
    f32x4 v[4]; float s = 0.f;
#pragma unroll
    for (int i = 0; i < 4; ++i) { v[i] = *(const f32x4*)(x + i * 256 + lane * 4); s += v[i][0] * v[i][0] + v[i][1] * v[i][1] + v[i][2] * v[i][2] + v[i][3] * v[i][3]; }
    s = wave_sum(s);
    const float rstd = rsqrtf(s * (1.0f / 1024.0f) + EPS);
    bf16_t* h = (bf16_t*)(p.ws + WS_H) + (size_t)row * 1024;
#pragma unroll
    for (int i = 0; i < 4; ++i) {
        const int c = i * 256 + lane * 4;
        const f32x4 gg = *(const f32x4*)(g + c), s1 = *(const f32x4*)(sc + c), s0 = *(const f32x4*)(sh + c);
        f32x4 o = v[i] * rstd * gg * (s1 + 1.0f) + s0;
        store_bf16x4(h + c, o);
    }
}
DI void final_norm_rows(const Params& p, int unit) {
    const int tid = threadIdx.x, wid = tid >> 6, lane = tid & 63;
    const int row = unit * 4 + wid;
    const float* x = (const float*)(p.ws + WS_XRES) + (size_t)row * 1024;
    const float* g = p.in[I_GFIN];
    f32x4 v[4]; float s = 0.f;
#pragma unroll
    for (int i = 0; i < 4; ++i) { v[i] = *(const f32x4*)(x + i * 256 + lane * 4); s += v[i][0] * v[i][0] + v[i][1] * v[i][1] + v[i][2] * v[i][2] + v[i][3] * v[i][3]; }
    s = wave_sum(s);
    const float rstd = rsqrtf(s * (1.0f / 1024.0f) + EPS);
    float* y = p.out + (size_t)row * 1024;
#pragma unroll
    for (int i = 0; i < 4; ++i) { const int c = i * 256 + lane * 4; *(f32x4*)(y + c) = v[i] * rstd * *(const f32x4*)(g + c); }
}

struct Soft { float m, l, o; };
DI void soft_step(Soft& s, float sc, float v) {
    const float mn = fmaxf(s.m, sc), a = __expf(s.m - mn), pp = __expf(sc - mn);
    s.l = s.l * a + pp; s.o = s.o * a + pp * v; s.m = mn;
}
DI void naive_attn_wave(const Params& p, int l, int wu) {
    const int lane = threadIdx.x & 63;
    unsigned char* ws = p.ws;
    const int mixer = wu / (NTOK * 4), r = wu % (NTOK * 4), t = r >> 2, hh = r & 3;
    const bool lat = t >= 4096;
    const int b = lat ? (t - 4096) >> 11 : t >> 8;
    const int own0 = lat ? 4096 + b * 2048 : b * 256, nown = lat ? 2048 : 256;
    bf16_t* mix = (bf16_t*)(ws + WS_MIX) + (size_t)t * 1024;
    if (mixer == 0) {
        const bf16_t* Q = (const bf16_t*)(ws + WS_QDA), *K = (const bf16_t*)(ws + WS_KDA), *V = (const bf16_t*)(ws + WS_VDA);
        const float q = bf2f(Q[(size_t)t * 256 + hh * 64 + lane]);
        const float scale = 0.17677669529663687f;
        Soft s1{-1e30f, 0.f, 0.f}, s2{-1e30f, 0.f, 0.f};
        for (int j = 0; j < nown + (lat ? 256 : 0); ++j) {
            float kk, vv;
            if (j < nown) { const size_t kr = (size_t)(own0 + j) * 256 + hh * 64 + lane; kk = bf2f(K[kr]); vv = bf2f(V[kr]); }
            else { const size_t kr = (((size_t)(l * 2 + b) * 4 + hh) * 256 + (j - nown)) * 64 + lane; kk = bf2f(((const bf16_t*)(ws + WS_KCDA))[kr]); vv = bf2f(((const bf16_t*)(ws + WS_VCDA))[kr]); }
            float pr = q * kk;
#pragma unroll
            for (int o = 16; o > 0; o >>= 1) pr += __shfl_xor(pr, o);
            const float sa = __shfl(pr, 0) * scale, sb = __shfl(pr, 32) * scale;
            soft_step(s1, sa, vv); soft_step(s2, sb, vv);
        }
        float e1 = 0.f, e2 = 0.f;
        for (int i = 0; i < 32; ++i) { e1 += p.in[I_LQ1][l * 32 + i] * p.in[I_LK1][l * 32 + i]; e2 += p.in[I_LQ2][l * 32 + i] * p.in[I_LK2][l * 32 + i]; }
        const float lam_init = 0.8f - 0.6f * expf(-0.3f * (float)l);
        const float lam = expf(e1) - expf(e2) + lam_init;
        const float o = s1.o / s1.l - lam * (s2.o / s2.l);
        const float ss = wave_sum(o * o) * (1.0f / 64.0f);
        const float y = o * rsqrtf(ss + EPS) * p.in[I_GSUB][l * 64 + lane] * (1.0f - lam_init);
        mix[hh * 64 + lane] = f2bf(y);
    } else if (mixer == 1) {
        const bf16_t* QM = (const bf16_t*)(ws + WS_QM), *KVM = (const bf16_t*)(ws + WS_KVM);
        const float qn = bf2f(QM[(size_t)t * 384 + hh * 64 + lane]);
        const float qr = lane < 32 ? bf2f(QM[(size_t)t * 384 + 256 + hh * 32 + lane]) : 0.f;
        const float scale = 0.10206207261596577f;
        Soft s1{-1e30f, 0.f, 0.f};
        for (int j = 0; j < nown + (lat ? 256 : 0); ++j) {
            size_t krow; float kr = 0.f;
            if (j < nown) { krow = own0 + j; if (lane < 32) kr = bf2f(((const bf16_t*)(ws + WS_KRA))[krow * 32 + lane]); }
            else { krow = 8192 + b * 256 + (j - nown); if (lane < 32) kr = bf2f(((const bf16_t*)(ws + WS_KRC))[((size_t)(l * 2 + b) * 256 + (j - nown)) * 32 + lane]); }
            const float kn = bf2f(KVM[krow * 512 + hh * 128 + lane]), vv = bf2f(KVM[krow * 512 + hh * 128 + 64 + lane]);
            const float sc = wave_sum(qn * kn + qr * kr) * scale;
            soft_step(s1, sc, vv);
        }
        mix[256 + hh * 64 + lane] = f2bf(s1.o / s1.l);
    } else {
        const bf16_t* Q = (const bf16_t*)(ws + WS_QNA), *K = (const bf16_t*)(ws + WS_KNA), *V = (const bf16_t*)(ws + WS_VNA);
        const float q = bf2f(Q[(size_t)t * 256 + hh * 64 + lane]);
        const float scale = 0.125f;
        Soft s1{-1e30f, 0.f, 0.f};
        if (!lat) {
            for (int j = 0; j < 256; ++j) {
                const size_t kr = (size_t)(own0 + j) * 256 + hh * 64 + lane;
                const float sc = wave_sum(q * bf2f(K[kr])) * scale;
                soft_step(s1, sc, bf2f(V[kr]));
            }
        } else {
            const int sl = t - own0, r0 = sl >> 6, w0 = sl & 63;
            const int rs = min(max(r0 - 4, 0), 24), cs = min(max(w0 - 8, 0), 48);
            const float* rpb = p.in[I_RPB] + ((size_t)l * 4 + hh) * 15 * 31;
            for (int a = 0; a < 8; ++a)
                for (int bc = 0; bc < 16; ++bc) {
                    const int kr_ = rs + a, kc_ = cs + bc;
                    const size_t kr = (size_t)(own0 + kr_ * 64 + kc_) * 256 + hh * 64 + lane;
                    const int dr = kr_ - r0 + 7, dc = min(max(kc_ - w0, -15), 15) + 15;
                    const float sc = wave_sum(q * bf2f(K[kr])) * scale + rpb[dr * 31 + dc];
                    soft_step(s1, sc, bf2f(V[kr]));
                }
            for (int j = 0; j < 256; ++j) {
                const size_t kr = (((size_t)(l * 2 + b) * 4 + hh) * 256 + j) * 64 + lane;
                const float sc = wave_sum(q * bf2f(((const bf16_t*)(ws + WS_KCNA))[kr])) * scale;
                soft_step(s1, sc, bf2f(((const bf16_t*)(ws + WS_VCNA))[kr]));
            }
        }
        mix[512 + hh * 64 + lane] = f2bf(s1.o / s1.l);
    }
}

DI void conv_unit(const Params& p, int l, int cu, LAS unsigned char* lds) {
    const int tid = threadIdx.x, c = tid, wid = tid >> 6, lane = tid & 63;
    unsigned char* ws = p.ws;
    const int t0 = cu * 32;
    const bool lat = t0 >= 4096;
    const int seq0 = lat ? 4096 + ((t0 - 4096) >> 11) * 2048 : (t0 >> 8) * 256, seqlen = lat ? 2048 : 256;
    const bf16_t* CU = (const bf16_t*)(ws + WS_CU);
    float g[62];
#pragma unroll
    for (int i = 0; i < 62; ++i) {
        const int s = t0 - seq0 + i - 15;
        float v = 0.f;
        if (s >= 0 && s < seqlen) { const size_t r = (size_t)(seq0 + s) * 512; const float a = bf2f(CU[r + c]), bb = bf2f(CU[r + 256 + c]); v = a / (1.f + __expf(-bb)); }
        g[i] = v;
    }
    float w[31];
#pragma unroll
    for (int j = 0; j < 31; ++j) w[j] = p.in[I_CDW][((size_t)l * 31 + j) * 256 + c];
    const float bias = p.in[I_CB][l * 256 + c];
    LAS float* y = (LAS float*)lds;
    __syncthreads();
#pragma unroll
    for (int i = 0; i < 32; ++i) {
        float a = bias;
#pragma unroll
        for (int j = 0; j < 31; ++j) a += g[i + j] * w[j];
        y[i * 256 + c] = a;
    }
    __syncthreads();
    const f32x4 lg = *(const f32x4*)(p.in[I_CLG] + l * 256 + lane * 4), lb = *(const f32x4*)(p.in[I_CLB] + l * 256 + lane * 4);
    for (int i = wid * 8; i < wid * 8 + 8; ++i) {
        f32x4 v = *(LAS const f32x4*)(y + i * 256 + lane * 4);
        const float mu = wave_sum(v[0] + v[1] + v[2] + v[3]) * (1.0f / 256.0f);
        const f32x4 d = v - mu;
        const float var = wave_sum(d[0] * d[0] + d[1] * d[1] + d[2] * d[2] + d[3] * d[3]) * (1.0f / 256.0f);
        const float rstd = rsqrtf(var + EPS);
        f32x4 o = d * rstd * lg + lb;
#pragma unroll
        for (int j = 0; j < 4; ++j) o[j] = o[j] / (1.f + __expf(-o[j]));
        store_bf16x4((bf16_t*)(ws + WS_MIX) + (size_t)(t0 + i) * 1024 + 768 + lane * 4, o);
    }
    __syncthreads();
}

template <int SUB>
__global__ void __launch_bounds__(256, 2) mk_phase(Params p, int l) {
    extern __shared__ __attribute__((aligned(16))) unsigned char smem[];
    LAS unsigned char* lds = (LAS unsigned char*)smem;
    unsigned char* ws = p.ws;
    const int G = gridDim.x, bid = blockIdx.x;
    if constexpr (SUB == 8) { for (int u = bid; u < N_PRO_UNITS; u += G) prologue_unit(p, u, lds); }
    else if constexpr (SUB == 9) { for (int u = bid; u < NTOK / 4; u += G) final_norm_rows(p, u); }
    else if constexpr (SUB == 0) { for (int u = bid; u < NTOK / 4; u += G) norm_rows(p, l, 0, u, l == 0); }
    else if constexpr (SUB == 5) { for (int u = bid; u < NTOK / 4; u += G) norm_rows(p, l, 1, u, false); }
    else if constexpr (SUB == 1) {
        const bf16_t* A = (const bf16_t*)(ws + WS_H); const bf16_t* Bt = (const bf16_t*)(ws + WS_WTIN) + (size_t)l * NIN * 1024;
        for (int u = bid; u < 64 * 20; u += G) { const int tm = u / 20, tn = u % 20; f32x4 acc[4][4]; gemm_tile(A, Bt, 1024, tm * 128, tn * 128, lds, acc); epi_inproj(p, l, acc, tm, tn, lds); }
    } else if constexpr (SUB == 2) {
        for (int u = bid; u < 64 * 3 + 68 * 4; u += G) {
            f32x4 acc[4][4];
            if (u < 192) { const int tm = u / 3, tn = u % 3; gemm_tile((const bf16_t*)(ws + WS_QD), (const bf16_t*)(ws + WS_WTQUP) + (size_t)l * 384 * 256, 256, tm * 128, tn * 128, lds, acc); epi_qup(p, acc, tm, tn); }
            else { const int v = u - 192, tm = v / 4, tn = v % 4; gemm_tile((const bf16_t*)(ws + WS_CKVA) + (size_t)l * 8704 * 128, (const bf16_t*)(ws + WS_WTKV) + (size_t)l * 512 * 128, 128, tm * 128, tn * 128, lds, acc); epi_kvup(p, acc, tm, tn); }
        }
    } else if constexpr (SUB == 3) {
        const int NAU = NTOK * 4 * 3 / 4;
        for (int u = bid; u < NAU + 256; u += G) {
            if (u < NAU) naive_attn_wave(p, l, u * 4 + (threadIdx.x >> 6));
            else conv_unit(p, l, u - NAU, lds);
        }
    } else if constexpr (SUB == 4) {
        const bf16_t* A = (const bf16_t*)(ws + WS_MIX); const bf16_t* Bt = (const bf16_t*)(ws + WS_WTOUT) + (size_t)l * 1024 * 1024;
        for (int u = bid; u < 64 * 8; u += G) { const int tm = u / 8, tn = u % 8; f32x4 acc[4][4]; gemm_tile(A, Bt, 1024, tm * 128, tn * 128, lds, acc); epi_resid(p, l, acc, tm, tn, 2, l == 0); }
    } else if constexpr (SUB == 6) {
        const bf16_t* A = (const bf16_t*)(ws + WS_H); const bf16_t* Bt = (const bf16_t*)(ws + WS_WTFF1) + (size_t)l * 4096 * 1024;
        for (int u = bid; u < 64 * 32; u += G) { const int tm = u / 32, tn = u % 32; f32x4 acc[4][4]; gemm_tile(A, Bt, 1024, tm * 128, tn * 128, lds, acc); epi_ff1(p, acc, tm, tn); }
    } else {
        const bf16_t* A = (const bf16_t*)(ws + WS_HBUF); const bf16_t* Bt = (const bf16_t*)(ws + WS_WTFF2) + (size_t)l * 1024 * 4096;
        for (int u = bid; u < 64 * 8; u += G) { const int tm = u / 8, tn = u % 8; f32x4 acc[4][4]; gemm_tile(A, Bt, 4096, tm * 128, tn * 128, lds, acc); epi_resid(p, l, acc, tm, tn, 5, false); }
    }
}


#ifndef DBG_STOP
#define DBG_STOP 99
#endif
#ifndef DBG_DUMP_OFF
#define DBG_DUMP_OFF WS_QD
#endif
__global__ void dbg_dump(Params p, size_t ws_off, size_t n_bf16, size_t out_off) {
    const bf16_t* s = (const bf16_t*)(p.ws + ws_off);
    for (size_t i = (size_t)blockIdx.x * 256 + threadIdx.x; i < n_bf16; i += (size_t)gridDim.x * 256) p.out[out_off + i] = bf2f(s[i]);
}
__global__ void dbg_dumpf(Params p, size_t ws_off, size_t n, size_t out_off) {
    const float* s = (const float*)(p.ws + ws_off);
    for (size_t i = (size_t)blockIdx.x * 256 + threadIdx.x; i < n; i += (size_t)gridDim.x * 256) p.out[out_off + i] = s[i];
}
template <int SUB> static void launch_phase(const Params& p, int l, int grid, hipStream_t stream) {
    hipLaunchKernelGGL(mk_phase<SUB>, dim3(grid), dim3(256), LDS_BYTES, stream, p, l);
}
extern "C" void kernel_launch(void* const* d_in, const int* in_sizes, int n_in, void* d_out, int out_size, void* d_ws, size_t ws_size, hipStream_t stream) {
    if (n_in != N_IN || ws_size < WS_END) { fprintf(stderr, "kernel_launch: unexpected n_in %d / ws_size %zu (need %zu)\n", n_in, ws_size, (size_t)WS_END); return; }
    Params p{};
    for (int i = 0; i < N_IN; ++i) p.in[i] = (const float*)d_in[i];
    p.out = (float*)d_out; p.ws = (unsigned char*)d_ws;
    int seq = 0;
#define STEP(call) do { if (seq < DBG_STOP) { call; } ++seq; } while (0)
    STEP(launch_phase<8>(p, 0, 1024, stream));
    for (int l = 0; l < NLAYER; ++l) {
        STEP(launch_phase<0>(p, l, 1024, stream));
        STEP(launch_phase<1>(p, l, 512, stream));
        STEP(launch_phase<2>(p, l, 512, stream));
        STEP(launch_phase<3>(p, l, 2048, stream));
        STEP(launch_phase<4>(p, l, 512, stream));
        STEP(launch_phase<5>(p, l, 1024, stream));
        STEP(launch_phase<6>(p, l, 512, stream));
        STEP(launch_phase<7>(p, l, 512, stream));
    }
    STEP(launch_phase<9>(p, 0, 1024, stream));
    if (DBG_STOP < 99) {
        hipLaunchKernelGGL(dbg_dump, dim3(2048), dim3(256), 0, stream, p, (size_t)WS_KVM, (size_t)4456448, (size_t)0);
    }
}
```

```cpp
#include <hip/hip_runtime.h>
#include <cstdint>
#include <cstdio>

typedef unsigned short bf16_t;
typedef short bf16x8 __attribute__((ext_vector_type(8)));
typedef float f32x4 __attribute__((ext_vector_type(4)));
typedef unsigned u32x2 __attribute__((ext_vector_type(2)));
typedef unsigned u32x4 __attribute__((ext_vector_type(4)));
#define LAS __attribute__((address_space(3)))
#define DI __device__ __forceinline__

constexpr int DM = 1024, NTOK = 8192, NCTXTOK = 4096, NLAYER = 2;
constexpr int NIN = 2560;
constexpr int DFF = 4096;
constexpr float EPS = 1e-6f;
enum { I_XP = 0, I_XS, I_C, I_CDAK, I_CDAV, I_CCKV, I_CKR, I_CNAK, I_CNAV, I_CCTX, I_WMOD, I_BMOD, I_GMIX, I_GFF, I_WIN,
       I_LQ1, I_LK1, I_LQ2, I_LK2, I_GSUB, I_GMQ, I_WQUP, I_GMKV, I_WKVUP, I_RPB, I_CDW, I_CB, I_CLG, I_CLB, I_WOUT, I_WFF1, I_WFF2, I_GFIN, N_IN };
constexpr size_t O_YP = 0, O_YS = 4194304, O_DAK = 8388608, O_DAV = 10485760, O_CKV = 12582912, O_KR = 13631488, O_NAK = 13893632, O_NAV = 15990784;

constexpr size_t al256(size_t x) { return (x + 255) & ~(size_t)255; }
constexpr size_t WS_BAR   = 0;
constexpr size_t WS_WTIN  = 16384;
constexpr size_t WS_WTQUP = WS_WTIN  + (size_t)NLAYER * NIN * 1024 * 2;
constexpr size_t WS_WTKV  = WS_WTQUP + (size_t)NLAYER * 384 * 256 * 2;
constexpr size_t WS_WTOUT = WS_WTKV  + (size_t)NLAYER * 512 * 128 * 2;
constexpr size_t WS_WTFF1 = WS_WTOUT + (size_t)NLAYER * 1024 * 1024 * 2;
constexpr size_t WS_WTFF2 = WS_WTFF1 + (size_t)NLAYER * 4096 * 1024 * 2;
constexpr size_t WS_MOD   = WS_WTFF2 + (size_t)NLAYER * 1024 * 4096 * 2;
constexpr size_t WS_ROPE  = WS_MOD   + (size_t)NLAYER * 3 * 6144 * 4;
constexpr size_t WS_H     = WS_ROPE  + 4096;
constexpr size_t WS_QDA   = WS_H     + (size_t)NTOK * 1024 * 2;
constexpr size_t WS_KDA   = WS_QDA   + (size_t)NTOK * 256 * 2;
constexpr size_t WS_VDA   = WS_KDA   + (size_t)NTOK * 256 * 2;
constexpr size_t WS_QNA   = WS_VDA   + (size_t)NTOK * 256 * 2;
constexpr size_t WS_KNA   = WS_QNA   + (size_t)NTOK * 256 * 2;
constexpr size_t WS_VNA   = WS_KNA   + (size_t)NTOK * 256 * 2;
constexpr size_t WS_QD    = WS_VNA   + (size_t)NTOK * 256 * 2;
constexpr size_t WS_SSQQ  = WS_QD    + (size_t)NTOK * 256 * 2;
constexpr size_t WS_CKVA  = WS_SSQQ  + (size_t)NTOK * 4 * 4;
constexpr size_t WS_KRA   = WS_CKVA  + (size_t)NLAYER * 8704 * 128 * 2;
constexpr size_t WS_KRC   = WS_KRA   + (size_t)NTOK * 32 * 2;
constexpr size_t WS_QM    = WS_KRC   + (size_t)NLAYER * 2 * 256 * 32 * 2;
constexpr size_t WS_KVM   = WS_QM    + (size_t)NTOK * 384 * 2;
constexpr size_t WS_KCDA  = WS_KVM   + (size_t)8704 * 512 * 2;
constexpr size_t WS_VCDA  = WS_KCDA  + (size_t)NLAYER * 2 * 4 * 256 * 64 * 2;
constexpr size_t WS_KCNA  = WS_VCDA  + (size_t)NLAYER * 2 * 4 * 256 * 64 * 2;
constexpr size_t WS_VCNA  = WS_KCNA  + (size_t)NLAYER * 2 * 4 * 256 * 64 * 2;
constexpr size_t WS_CU    = WS_VCNA  + (size_t)NLAYER * 2 * 4 * 256 * 64 * 2;
constexpr size_t WS_MIX   = WS_CU    + (size_t)NTOK * 512 * 2;
constexpr size_t WS_XRES  = WS_MIX   + (size_t)NTOK * 1024 * 2;
constexpr size_t WS_HBUF  = WS_XRES  + (size_t)NTOK * 1024 * 4;
constexpr size_t WS_END   = WS_HBUF  + (size_t)NTOK * 4096 * 2;

struct Params {
    const float* in[N_IN];
    float* out;
    unsigned char* ws;
};

constexpr int LDS_BYTES = 65536 + 64;

typedef float f32x2 __attribute__((ext_vector_type(2)));
typedef __bf16 bf16x2v __attribute__((ext_vector_type(2)));
DI unsigned cvt_pk_bf16(float lo, float hi) { f32x2 v = {lo, hi}; return __builtin_bit_cast(unsigned, __builtin_convertvector(v, bf16x2v)); }
DI bf16_t f2bf(float x) { unsigned u = __float_as_uint(x); u += 0x7fffu + ((u >> 16) & 1u); return (bf16_t)(u >> 16); }
DI float bf2f(bf16_t v) { return __uint_as_float(((unsigned)v) << 16); }
DI int opaque_tid() { int t = threadIdx.x; asm volatile("" : "+v"(t)); return t; }
DI float wave_sum(float v) {
#pragma unroll
    for (int o = 32; o > 0; o >>= 1) v += __shfl_xor(v, o);
    return v;
}
DI int seg_of_row(int row) { return row < 4096 ? 0 : (row < 6144 ? 1 : 2); }
DI const float* x_in_row(const Params& p, int row) { return row < 4096 ? p.in[I_XP] + (size_t)row * 1024 : p.in[I_XS] + (size_t)(row - 4096) * 1024; }

DI void gemm_stage(const bf16_t* __restrict__ A, const bf16_t* __restrict__ Bt, int K, int row0, int col0, int k0, LAS unsigned char* lds_stage, int tid) {
#pragma unroll
    for (int i = 0; i < 4; ++i) {
        const int b = i * 4096 + tid * 16, row = b >> 7, pch = (b >> 4) & 7, lch = pch ^ ((row >> 1) & 7);
        const bf16_t* ga = A + (size_t)(row0 + row) * K + k0 + lch * 8;
        const bf16_t* gb = Bt + (size_t)(col0 + row) * K + k0 + lch * 8;
        __builtin_amdgcn_global_load_lds((const unsigned*)ga, (LAS unsigned*)(lds_stage + b), 16, 0, 0);
        __builtin_amdgcn_global_load_lds((const unsigned*)gb, (LAS unsigned*)(lds_stage + 16384 + b), 16, 0, 0);
    }
}

DI void gemm_tile(const bf16_t* __restrict__ A, const bf16_t* __restrict__ Bt, int K, int row0, int col0, LAS unsigned char* lds, f32x4 (&acc)[4][4]) {
    const int tid = opaque_tid(), wid = tid >> 6, lane = tid & 63, wr = wid >> 1, wc = wid & 1, fr = lane & 15, fq = lane >> 4;
#pragma unroll
    for (int m = 0; m < 4; ++m)
#pragma unroll
        for (int n = 0; n < 4; ++n) acc[m][n] = (f32x4){0.f, 0.f, 0.f, 0.f};
    const int sw = (fr >> 1) & 7;
    const int offk0 = ((0 + fq) ^ sw) << 4, offk1 = ((4 + fq) ^ sw) << 4;
    const int abase = (wr * 64 + fr) * 128, bbase = 16384 + (wc * 64 + fr) * 128;
    const int nt = K >> 6;
    __syncthreads();
    gemm_stage(A, Bt, K, row0, col0, 0, lds, tid);
    for (int t = 0; t < nt; ++t) {
        asm volatile("s_waitcnt vmcnt(0)" ::: "memory");
        __syncthreads();
        if (t + 1 < nt) gemm_stage(A, Bt, K, row0, col0, (t + 1) << 6, lds + ((t + 1) & 1) * 32768, tid);
        LAS const unsigned char* st = lds + (t & 1) * 32768;
        bf16x8 af[4][2], bfr[4][2];
#pragma unroll
        for (int m = 0; m < 4; ++m) {
            af[m][0] = *(LAS const bf16x8*)(st + abase + m * 2048 + offk0);
            af[m][1] = *(LAS const bf16x8*)(st + abase + m * 2048 + offk1);
        }
#pragma unroll
        for (int n = 0; n < 4; ++n) {
            bfr[n][0] = *(LAS const bf16x8*)(st + bbase + n * 2048 + offk0);
            bfr[n][1] = *(LAS const bf16x8*)(st + bbase + n * 2048 + offk1);
        }
#pragma unroll
        for (int k = 0; k < 2; ++k)
#pragma unroll
            for (int m = 0; m < 4; ++m)
#pragma unroll
                for (int n = 0; n < 4; ++n)
                    acc[m][n] = __builtin_amdgcn_mfma_f32_16x16x32_bf16(bfr[n][k], af[m][k], acc[m][n], 0, 0, 0);
    }
}

DI f32x4 rope4(f32x4 v, const float* __restrict__ ropetab, int pos, int fq) {
    const f32x4 cs = *(const f32x4*)(ropetab + pos * 8 + 4 * (fq & 1));
    const f32x4 sn = *(const f32x4*)(ropetab + 512 + pos * 8 + 4 * (fq & 1));
    f32x4 o;
#pragma unroll
    for (int j = 0; j < 4; ++j) {
        const float pr = __shfl_xor(v[j], 32);
        o[j] = (fq >= 2) ? (pr * sn[j] + v[j] * cs[j]) : (v[j] * cs[j] - pr * sn[j]);
    }
    return o;
}
DI void store_bf16x4(bf16_t* dst, f32x4 v) { u32x2 w; w.x = cvt_pk_bf16(v[0], v[1]); w.y = cvt_pk_bf16(v[2], v[3]); *(u32x2*)dst = w; }

DI void epi_inproj(const Params& p, int l, f32x4 (&acc)[4][4], int tm, int tn, LAS unsigned char* lds) {
    const int tid = opaque_tid(), wid = tid >> 6, lane = tid & 63, wr = wid >> 1, wc = wid & 1, fr = lane & 15, fq = lane >> 4;
    unsigned char* ws = p.ws;
    const bool lat = tm >= 32;
    const float* ropetab = (const float*)(ws + WS_ROPE);
    float* out = p.out;
    if (tn == 8) {
        LAS float* ex = (LAS float*)lds;
        __syncthreads();
#pragma unroll
        for (int m = 0; m < 4; ++m) {
            float s = 0.f;
#pragma unroll
            for (int n = 0; n < 4; ++n)
#pragma unroll
                for (int j = 0; j < 4; ++j) s += acc[m][n][j] * acc[m][n][j];
            s += __shfl_xor(s, 16); s += __shfl_xor(s, 32);
            if (fq == 0) ex[(wr * 64 + m * 16 + fr) * 2 + wc] = s;
        }
        __syncthreads();
        const float* gkv = p.in[I_GMKV] + l * 128;
        bf16_t* ckva = (bf16_t*)(ws + WS_CKVA) + (size_t)l * 8704 * 128;
#pragma unroll
        for (int m = 0; m < 4; ++m) {
            const int rl = wr * 64 + m * 16 + fr, row = tm * 128 + rl;
            const float rstd = rsqrtf((ex[rl * 2] + ex[rl * 2 + 1]) * (1.0f / 128.0f) + EPS);
#pragma unroll
            for (int n = 0; n < 4; ++n) {
                const int col = wc * 64 + n * 16 + 4 * fq;
                const f32x4 g = *(const f32x4*)(gkv + col);
                f32x4 v = acc[m][n] * rstd * g;
                store_bf16x4(ckva + (size_t)row * 128 + col, v);
                if (!lat) { const int b = row >> 8, s = row & 255; *(f32x4*)(out + O_CKV + ((size_t)(b * 2 + l) * 256 + s) * 128 + col) = v; }
            }
        }
        __syncthreads();
        return;
    }
#pragma unroll
    for (int m = 0; m < 4; ++m) {
        const int row = tm * 128 + wr * 64 + m * 16 + fr;
        const int sl = (row - 4096) & 2047, prow = sl >> 6, pcol = sl & 63;
        const int cb = row >> 8, cs = row & 255;
        if (tn == 6 || tn == 7) {
            float s = 0.f;
#pragma unroll
            for (int n = 0; n < 4; ++n)
#pragma unroll
                for (int j = 0; j < 4; ++j) s += acc[m][n][j] * acc[m][n][j];
            s += __shfl_xor(s, 16); s += __shfl_xor(s, 32);
            if (fq == 0) ((float*)(ws + WS_SSQQ))[row * 4 + (tn - 6) * 2 + wc] = s;
        }
#pragma unroll
        for (int n = 0; n < 4; ++n) {
            const int cw = wc * 64 + n * 16 + 4 * fq;
            f32x4 v = acc[m][n];
            if (tn < 2) {
                if (lat) v = rope4(v, ropetab, (n & 1) ? pcol : prow, fq);
                store_bf16x4((bf16_t*)(ws + WS_QDA) + (size_t)row * 256 + tn * 128 + cw, v);
            } else if (tn < 4) {
                if (lat) v = rope4(v, ropetab, (n & 1) ? pcol : prow, fq);
                const int c = (tn - 2) * 128 + cw;
                store_bf16x4((bf16_t*)(ws + WS_KDA) + (size_t)row * 256 + c, v);
                if (!lat) *(f32x4*)(out + O_DAK + (((size_t)(cb * 2 + l) * 4 + (c >> 6)) * 256 + cs) * 64 + (c & 63)) = v;
            } else if (tn < 6) {
                const int c = (tn - 4) * 128 + cw;
                store_bf16x4((bf16_t*)(ws + WS_VDA) + (size_t)row * 256 + c, v);
                if (!lat) *(f32x4*)(out + O_DAV + (((size_t)(cb * 2 + l) * 4 + (c >> 6)) * 256 + cs) * 64 + (c & 63)) = v;
            } else if (tn < 8) {
                store_bf16x4((bf16_t*)(ws + WS_QD) + (size_t)row * 256 + (tn - 6) * 128 + cw, v);
            } else if (tn < 11) {
                store_bf16x4((bf16_t*)(ws + WS_QNA) + (size_t)row * 256 + (tn - 9) * 128 + cw, v);
            } else if (tn < 13) {
                const int c = (tn - 11) * 128 + cw;
                store_bf16x4((bf16_t*)(ws + WS_KNA) + (size_t)row * 256 + c, v);
                if (!lat) *(f32x4*)(out + O_NAK + (((size_t)(cb * 2 + l) * 4 + (c >> 6)) * 256 + cs) * 64 + (c & 63)) = v;
            } else if (tn < 15) {
                const int c = (tn - 13) * 128 + cw;
                store_bf16x4((bf16_t*)(ws + WS_VNA) + (size_t)row * 256 + c, v);
                if (!lat) *(f32x4*)(out + O_NAV + (((size_t)(cb * 2 + l) * 4 + (c >> 6)) * 256 + cs) * 64 + (c & 63)) = v;
            } else if (tn < 19) {
                store_bf16x4((bf16_t*)(ws + WS_CU) + (size_t)row * 512 + (tn - 15) * 128 + cw, v);
            } else {
                if (lat) v = rope4(v, ropetab, (n & 1) ? pcol : prow, fq);
                if (wc == 0 && n < 2) {
                    store_bf16x4((bf16_t*)(ws + WS_KRA) + (size_t)row * 32 + cw, v);
                    if (!lat) *(f32x4*)(out + O_KR + ((size_t)(cb * 2 + l) * 256 + cs) * 32 + cw) = v;
                }
            }
        }
    }
}

DI void epi_qup(const Params& p, f32x4 (&acc)[4][4], int tm, int tn) {
    const int tid = opaque_tid(), wid = tid >> 6, lane = tid & 63, wr = wid >> 1, wc = wid & 1, fr = lane & 15, fq = lane >> 4;
    unsigned char* ws = p.ws;
    const bool lat = tm >= 32;
    const float* ropetab = (const float*)(ws + WS_ROPE);
#pragma unroll
    for (int m = 0; m < 4; ++m) {
        const int row = tm * 128 + wr * 64 + m * 16 + fr;
        const int sl = (row - 4096) & 2047, prow = sl >> 6, pcol = sl & 63;
        const f32x4 sq = *(const f32x4*)((const float*)(ws + WS_SSQQ) + row * 4);
        const float rstd = rsqrtf((sq[0] + sq[1] + sq[2] + sq[3]) * (1.0f / 256.0f) + EPS);
#pragma unroll
        for (int n = 0; n < 4; ++n) {
            f32x4 v = acc[m][n] * rstd;
            if (tn == 2 && lat) v = rope4(v, ropetab, (n & 1) ? pcol : prow, fq);
            store_bf16x4((bf16_t*)(ws + WS_QM) + (size_t)row * 384 + tn * 128 + wc * 64 + n * 16 + 4 * fq, v);
        }
    }
}
DI void epi_kvup(const Params& p, f32x4 (&acc)[4][4], int tm, int tn) {
    const int tid = opaque_tid(), wid = tid >> 6, lane = tid & 63, wr = wid >> 1, wc = wid & 1, fr = lane & 15, fq = lane >> 4;
#pragma unroll
    for (int m = 0; m < 4; ++m) {
        const int row = tm * 128 + wr * 64 + m * 16 + fr;
#pragma unroll
        for (int n = 0; n < 4; ++n) store_bf16x4((bf16_t*)(p.ws + WS_KVM) + (size_t)row * 512 + tn * 128 + wc * 64 + n * 16 + 4 * fq, acc[m][n]);
    }
}
DI void epi_resid(const Params& p, int l, f32x4 (&acc)[4][4], int tm, int tn, int gi, bool from_input) {
    const int tid = opaque_tid(), wid = tid >> 6, lane = tid & 63, wr = wid >> 1, wc = wid & 1, fr = lane & 15, fq = lane >> 4;
    float* xres = (float*)(p.ws + WS_XRES);
    const int seg = seg_of_row(tm * 128);
    const float* gate = (const float*)(p.ws + WS_MOD) + ((size_t)l * 3 + seg) * 6144 + gi * 1024;
#pragma unroll
    for (int m = 0; m < 4; ++m) {
        const int row = tm * 128 + wr * 64 + m * 16 + fr;
        const float* src = from_input ? x_in_row(p, row) : xres + (size_t)row * 1024;
#pragma unroll
        for (int n = 0; n < 4; ++n) {
            const int col = tn * 128 + wc * 64 + n * 16 + 4 * fq;
            const f32x4 g = *(const f32x4*)(gate + col);
            const f32x4 xv = *(const f32x4*)(src + col);
            *(f32x4*)(xres + (size_t)row * 1024 + col) = xv + g * acc[m][n];
        }
    }
}
DI void epi_ff1(const Params& p, f32x4 (&acc)[4][4], int tm, int tn) {
    const int tid = opaque_tid(), wid = tid >> 6, lane = tid & 63, wr = wid >> 1, wc = wid & 1, fr = lane & 15, fq = lane >> 4;
#pragma unroll
    for (int m = 0; m < 4; ++m) {
        const int row = tm * 128 + wr * 64 + m * 16 + fr;
#pragma unroll
        for (int n = 0; n < 4; ++n) {
            f32x4 v = acc[m][n];
#pragma unroll
            for (int j = 0; j < 4; ++j) { const float r = fmaxf(v[j], 0.f); v[j] = r * r; }
            store_bf16x4((bf16_t*)(p.ws + WS_HBUF) + (size_t)row * 4096 + tn * 128 + wc * 64 + n * 16 + 4 * fq, v);
        }
    }
}

DI void transpose_tile(const float* __restrict__ src, int ld_src, bf16_t* __restrict__ dst, int K, int k0, int n0, int mode, const float* __restrict__ kscale, LAS float* t) {
    const int tid = opaque_tid(), ty = tid >> 4, tx = tid & 15;
    const int nd = n0 + 4 * tx;
    int sc;
    if (mode == 0) {
        if (nd < 1152) sc = nd; else if (nd < 2432) sc = nd + 32; else if (nd < 2464) sc = nd - 2432 + 1152; else sc = -1;
    } else if (mode == 1) {
        if (nd < 256) sc = (nd >> 6) * 96 + (nd & 63); else { const int r = nd - 256; sc = (r >> 5) * 96 + 64 + (r & 31); }
    } else sc = nd;
    __syncthreads();
#pragma unroll
    for (int i = 0; i < 4; ++i) {
        const int kk = ty + 16 * i;
        f32x4 v = (f32x4){0.f, 0.f, 0.f, 0.f};
        if (sc >= 0) v = *(const f32x4*)(src + (size_t)(k0 + kk) * ld_src + sc);
        if (kscale) v = v * kscale[k0 + kk];
        t[kk * 65 + 4 * tx + 0] = v[0]; t[kk * 65 + 4 * tx + 1] = v[1]; t[kk * 65 + 4 * tx + 2] = v[2]; t[kk * 65 + 4 * tx + 3] = v[3];
    }
    __syncthreads();
    const int nn = tid >> 2, kc = tid & 3;
    unsigned w[8];
#pragma unroll
    for (int e = 0; e < 8; ++e) w[e] = cvt_pk_bf16(t[(kc * 16 + 2 * e) * 65 + nn], t[(kc * 16 + 2 * e + 1) * 65 + nn]);
    bf16_t* d = dst + (size_t)(n0 + nn) * K + k0 + kc * 16;
    *(u32x4*)d = (u32x4){w[0], w[1], w[2], w[3]};
    *(u32x4*)(d + 8) = (u32x4){w[4], w[5], w[6], w[7]};
}

constexpr int TR_PER_LAYER = 640 + 24 + 16 + 256 + 1024 + 1024;
constexpr int N_TR = NLAYER * TR_PER_LAYER;
constexpr int N_MODU = NLAYER * 48 * 2;
constexpr int N_CACHE_ELEMS = NLAYER * 2 * (4 * 256 * 64 * 4 + 256 * 128 + 256 * 32);
constexpr int N_CACHEU = (N_CACHE_ELEMS / 4 + 255) / 256;

DI void prologue_unit(const Params& p, int u, LAS unsigned char* lds) {
    unsigned char* ws = p.ws;
    const int tid = opaque_tid();
    if (u < N_TR) {
        const int l = u / TR_PER_LAYER; int r = u % TR_PER_LAYER;
        LAS float* t = (LAS float*)lds;
        if (r < 640) { transpose_tile(p.in[I_WIN] + (size_t)l * 1024 * 2464, 2464, (bf16_t*)(ws + WS_WTIN) + (size_t)l * NIN * 1024, 1024, (r / 40) * 64, (r % 40) * 64, 0, nullptr, t); return; }
        r -= 640;
        if (r < 24) { transpose_tile(p.in[I_WQUP] + (size_t)l * 256 * 384, 384, (bf16_t*)(ws + WS_WTQUP) + (size_t)l * 384 * 256, 256, (r / 6) * 64, (r % 6) * 64, 1, p.in[I_GMQ] + l * 256, t); return; }
        r -= 24;
        if (r < 16) { transpose_tile(p.in[I_WKVUP] + (size_t)l * 128 * 512, 512, (bf16_t*)(ws + WS_WTKV) + (size_t)l * 512 * 128, 128, (r / 8) * 64, (r % 8) * 64, 2, nullptr, t); return; }
        r -= 16;
        if (r < 256) { transpose_tile(p.in[I_WOUT] + (size_t)l * 1024 * 1024, 1024, (bf16_t*)(ws + WS_WTOUT) + (size_t)l * 1024 * 1024, 1024, (r / 16) * 64, (r % 16) * 64, 2, nullptr, t); return; }
        r -= 256;
        if (r < 1024) { transpose_tile(p.in[I_WFF1] + (size_t)l * 1024 * 4096, 4096, (bf16_t*)(ws + WS_WTFF1) + (size_t)l * 4096 * 1024, 1024, (r / 64) * 64, (r % 64) * 64, 2, nullptr, t); return; }
        r -= 1024;
        transpose_tile(p.in[I_WFF2] + (size_t)l * 4096 * 1024, 1024, (bf16_t*)(ws + WS_WTFF2) + (size_t)l * 1024 * 4096, 4096, (r / 16) * 64, (r % 16) * 64, 2, nullptr, t);
        return;
    }
    u -= N_TR;
    if (u < N_MODU) {
        const int l = u / 96, cchunk = u % 96;
        const int cg = tid & 15, ks = tid >> 4;
        const int col = cchunk * 64 + cg * 4;
        const float* wm = p.in[I_WMOD] + (size_t)l * 1024 * 6144;
        f32x4 a0 = (f32x4){0.f, 0.f, 0.f, 0.f}, a1 = a0, a2 = a0;
        for (int k = ks * 64; k < ks * 64 + 64; ++k) {
            const f32x4 w = *(const f32x4*)(wm + (size_t)k * 6144 + col);
            float c0 = p.in[I_CCTX][k], c1 = p.in[I_C][k], c2 = p.in[I_C][1024 + k];
            c0 = c0 / (1.f + __expf(-c0)); c1 = c1 / (1.f + __expf(-c1)); c2 = c2 / (1.f + __expf(-c2));
            a0 += w * c0; a1 += w * c1; a2 += w * c2;
        }
        LAS float* red = (LAS float*)lds;
        __syncthreads();
#pragma unroll
        for (int j = 0; j < 4; ++j) { red[(ks * 16 + cg) * 12 + j] = a0[j]; red[(ks * 16 + cg) * 12 + 4 + j] = a1[j]; red[(ks * 16 + cg) * 12 + 8 + j] = a2[j]; }
        __syncthreads();
        if (tid < 192) {
            const int cgi = tid / 12, e = tid % 12;
            float s = 0.f;
#pragma unroll
            for (int k2 = 0; k2 < 16; ++k2) s += red[(k2 * 16 + cgi) * 12 + e];
            const int seg = e >> 2, c = cchunk * 64 + cgi * 4 + (e & 3);
            ((float*)(ws + WS_MOD))[((size_t)l * 3 + seg) * 6144 + c] = s + p.in[I_BMOD][(size_t)l * 6144 + c];
        }
        __syncthreads();
        return;
    }
    u -= N_MODU;
    if (u < N_CACHEU) {
        const int e4 = (u * 256 + tid) * 4;
        if (e4 >= N_CACHE_ELEMS) return;
        constexpr int PER_LB = 4 * 256 * 64 * 4 + 256 * 128 + 256 * 32;
        const int lb = e4 / PER_LB, r = e4 % PER_LB, l = lb >> 1, b = lb & 1;
        const float* src; bf16_t* dst;
        if (r < 4 * 65536) {
            const int which = r >> 16, off = r & 65535;
            const int ii = which == 0 ? I_CDAK : which == 1 ? I_CDAV : which == 2 ? I_CNAK : I_CNAV;
            const size_t wo = which == 0 ? WS_KCDA : which == 1 ? WS_VCDA : which == 2 ? WS_KCNA : WS_VCNA;
            src = p.in[ii] + ((size_t)(b * 2 + l)) * 65536 + off;
            dst = (bf16_t*)(ws + wo) + ((size_t)(l * 2 + b)) * 65536 + off;
        } else if (r < 4 * 65536 + 32768) {
            const int off = r - 4 * 65536;
            src = p.in[I_CCKV] + ((size_t)(b * 2 + l)) * 32768 + off;
            dst = (bf16_t*)(ws + WS_CKVA) + ((size_t)l * 8704 + 8192 + b * 256) * 128 + off;
        } else {
            const int off = r - 4 * 65536 - 32768;
            src = p.in[I_CKR] + ((size_t)(b * 2 + l)) * 8192 + off;
            dst = (bf16_t*)(ws + WS_KRC) + ((size_t)(l * 2 + b)) * 8192 + off;
        }
        const f32x4 v = *(const f32x4*)src;
        store_bf16x4(dst, v);
        return;
    }
    u -= N_CACHEU;
    for (int e = tid; e < 512; e += 256) {
        const int pos = e >> 3, i = e & 7;
        const float freq = powf(10000.0f, -(float)i / 8.0f);
        const float ang = (float)pos * freq;
        ((float*)(ws + WS_ROPE))[e] = cosf(ang);
        ((float*)(ws + WS_ROPE))[512 + e] = sinf(ang);
    }
}
constexpr int N_PRO_UNITS = N_TR + N_MODU + N_CACHEU + 1;

DI void norm_rows(const Params& p, int l, int which, int unit, bool from_input) {
    const int tid = opaque_tid(), wid = tid >> 6, lane = tid & 63;
    const int row = unit * 4 + wid;
    const float* x = from_input ? x_in_row(p, row) : (const float*)(p.ws + WS_XRES) + (size_t)row * 1024;
    const int seg = seg_of_row(row);
    const float* mod = (const float*)(p.ws + WS_MOD) + ((size_t)l * 3 + seg) * 6144;
    const float* sh = mod + (which ? 3 : 0) * 1024, *sc = mod + (which ? 4 : 1) * 1024;
    const float* g = p.in[which ? I_GFF : I_GMIX] + l * 1024;
    f32x4 v[4]; float s = 0.f;
#pragma unroll
    for (int i = 0; i < 4; ++i) { v[i] = *(const f32x4*)(x + i * 256 + lane * 4); s += v[i][0] * v[i][0] + v[i][1] * v[i][1] + v[i][2] * v[i][2] + v[i][3] * v[i][3]; }
    s = wave_sum(s);
    const float rstd = rsqrtf(s * (1.0f / 1024.0f) + EPS);
    bf16_t* h = (bf16_t*)(p.ws + WS_H) + (size_t)row * 1024;
#pragma unroll
    for (int i = 0; i < 4; ++i) {
        const int c = i * 256 + lane * 4;
        const f32x4 gg = *(const f32x4*)(g + c), s1 = *(const f32x4*)(sc + c), s0 = *(const f32x4*)(sh + c);
        f32x4 o = v[i] * rstd * gg * (s1 + 1.0f) + s0;
        store_bf16x4(h + c, o);
    }
}
DI void final_norm_rows(const Params& p, int unit) {
    const int tid = opaque_tid(), wid = tid >> 6, lane = tid & 63;
    const int row = unit * 4 + wid;
    const float* x = (const float*)(p.ws + WS_XRES) + (size_t)row * 1024;
    const float* g = p.in[I_GFIN];
    f32x4 v[4]; float s = 0.f;
#pragma unroll
    for (int i = 0; i < 4; ++i) { v[i] = *(const f32x4*)(x + i * 256 + lane * 4); s += v[i][0] * v[i][0] + v[i][1] * v[i][1] + v[i][2] * v[i][2] + v[i][3] * v[i][3]; }
    s = wave_sum(s);
    const float rstd = rsqrtf(s * (1.0f / 1024.0f) + EPS);
    float* y = p.out + (size_t)row * 1024;
#pragma unroll
    for (int i = 0; i < 4; ++i) { const int c = i * 256 + lane * 4; *(f32x4*)(y + c) = v[i] * rstd * *(const f32x4*)(g + c); }
}


typedef short s16x4 __attribute__((ext_vector_type(4)));
DI s16x4 lds_tr16(LAS const unsigned char* p) { return __builtin_bit_cast(s16x4, __builtin_amdgcn_ds_read_tr16_b64_v4i16((LAS s16x4*)p)); }
constexpr int AT_K = 0, AT_R = 8192, AT_V = 12288, AT_BUF = 20480, AT_RPB = 40960;
constexpr float LOG2E = 1.4426950408889634f;

struct TileSrc { const unsigned char* k; const unsigned char* v; const unsigned char* r; int pk, pv, pr; };

template <int MODE>
DI TileSrc attn_tile_src(const Params& p, int l, int b, int hh, bool lat, int own0, int na_rs, int t) {
    unsigned char* ws = p.ws; TileSrc s; s.r = nullptr; s.pr = 0;
    const int nct = lat ? 4 : 0;
    if (t < nct) {
        if (MODE == 1) {
            const size_t krow = 8192 + b * 256 + t * 64;
            s.k = ws + WS_KVM + (krow * 512 + hh * 128) * 2; s.v = s.k + 128; s.pk = s.pv = 1024;
            s.r = ws + WS_KRC + ((size_t)(l * 2 + b) * 256 + t * 64) * 64; s.pr = 64;
        } else {
            const size_t off = ((((size_t)(l * 2 + b) * 4 + hh) * 256) + t * 64) * 128;
            s.k = ws + (MODE == 0 ? WS_KCDA : WS_KCNA) + off; s.v = ws + (MODE == 0 ? WS_VCDA : WS_VCNA) + off; s.pk = s.pv = 128;
        }
    } else {
        const int a = t - nct;
        const size_t row = own0 + (size_t)((MODE == 2 && lat) ? (na_rs + a) : a) * 64;
        if (MODE == 1) {
            s.k = ws + WS_KVM + (row * 512 + hh * 128) * 2; s.v = s.k + 128; s.pk = s.pv = 1024;
            s.r = ws + WS_KRA + row * 64; s.pr = 64;
        } else {
            s.k = ws + (MODE == 0 ? WS_KDA : WS_KNA) + (row * 256 + hh * 64) * 2; s.v = ws + (MODE == 0 ? WS_VDA : WS_VNA) + (row * 256 + hh * 64) * 2; s.pk = s.pv = 512;
        }
    }
    return s;
}

template <int MODE>
DI void attn_unit(const Params& p, int l, int b, int hh, bool lat, int q0tok, int own0, int ntiles, int na_r, LAS unsigned char* lds) {
    const int tid = opaque_tid(), wv = tid >> 6, lane = tid & 63, g = lane >> 4, c = lane & 15;
    unsigned char* ws = p.ws;
    constexpr int NMAP = (MODE == 0) ? 2 : 1;
    constexpr int NKS = (MODE == 0) ? 1 : (MODE == 1 ? 3 : 2);
    const float scale = (MODE == 0) ? 0.17677669529663687f : (MODE == 1 ? 0.10206207261596577f : 0.125f);
    const float c1 = scale * LOG2E;
    const int na_rs = (MODE == 2 && lat) ? min(max(na_r - 4, 0), 24) : 0;
    const bool na_loc = (MODE == 2 && lat);
    const int qtok = q0tok + wv * 16 + c;
    bf16x8 qf[NMAP][NKS];
    if (MODE == 0) {
        const bf16_t* q = (const bf16_t*)(ws + WS_QDA) + (size_t)qtok * 256 + hh * 64;
        qf[0][0] = *(const bf16x8*)(q + 8 * g); qf[NMAP - 1][0] = *(const bf16x8*)(q + 32 + 8 * g);
    } else if (MODE == 1) {
        const bf16_t* q = (const bf16_t*)(ws + WS_QM) + (size_t)qtok * 384;
        qf[0][0] = *(const bf16x8*)(q + hh * 64 + 8 * g); qf[0][1 % NKS] = *(const bf16x8*)(q + hh * 64 + 32 + 8 * g); qf[0][2 % NKS] = *(const bf16x8*)(q + 256 + hh * 32 + 8 * g);
    } else {
        const bf16_t* q = (const bf16_t*)(ws + WS_QNA) + (size_t)qtok * 256 + hh * 64;
        qf[0][0] = *(const bf16x8*)(q + 8 * g); qf[0][1 % NKS] = *(const bf16x8*)(q + 32 + 8 * g);
    }
    const int rowA = tid >> 3, chA = tid & 7, rowB = rowA + 32;
    const int kdstA = rowA * 128 + ((chA ^ ((rowA >> 1) & 7)) << 4), kdstB = rowB * 128 + ((chA ^ ((rowB >> 1) & 7)) << 4);
    const int vdstA = rowA * 128 + ((chA ^ (((rowA >> 1) & 3) << 1)) << 4), vdstB = rowB * 128 + ((chA ^ (((rowB >> 1) & 3) << 1)) << 4);
    const int rrow = tid >> 2, rch = tid & 3, rdst = rrow * 64 + ((rch ^ ((-(rrow >> 2)) & 3)) << 4);
    u32x4 rk0, rk1, rv0, rv1, rr0;
    rr0 = (u32x4){0u, 0u, 0u, 0u};
#define AT_LOAD(t_) do { const TileSrc s_ = attn_tile_src<MODE>(p, l, b, hh, lat, own0, na_rs, (t_)); \
        rk0 = *(const u32x4*)(s_.k + (size_t)rowA * s_.pk + chA * 16); rk1 = *(const u32x4*)(s_.k + (size_t)rowB * s_.pk + chA * 16); \
        rv0 = *(const u32x4*)(s_.v + (size_t)rowA * s_.pv + chA * 16); rv1 = *(const u32x4*)(s_.v + (size_t)rowB * s_.pv + chA * 16); \
        if (MODE == 1) rr0 = *(const u32x4*)(s_.r + (size_t)rrow * s_.pr + rch * 16); } while (0)
#define AT_WRITE(buf_) do { LAS unsigned char* d_ = lds + (buf_) * AT_BUF; \
        *(LAS u32x4*)(d_ + AT_K + kdstA) = rk0; *(LAS u32x4*)(d_ + AT_K + kdstB) = rk1; \
        *(LAS u32x4*)(d_ + AT_V + vdstA) = rv0; *(LAS u32x4*)(d_ + AT_V + vdstB) = rv1; \
        if (MODE == 1) *(LAS u32x4*)(d_ + AT_R + rdst) = rr0; } while (0)
    __syncthreads();
    if (na_loc) {
        const float* rpb = p.in[I_RPB] + ((size_t)l * 4 + hh) * 465;
        for (int e = tid; e < 465; e += 256) ((LAS float*)(lds + AT_RPB))[e] = rpb[e] * LOG2E;
    }
    AT_LOAD(0); AT_WRITE(0);
    if (ntiles > 1) AT_LOAD(1);
    __syncthreads();
    const int ksw = (c >> 1) & 7;
    const int koff0 = c * 128 + ((g ^ ksw) << 4), koff1 = c * 128 + (((4 + g) ^ ksw) << 4);
    const int roff = c * 64 + ((g ^ ((-(c >> 2)) & 3)) << 4);
    const int vq = c >> 2, vpp = c & 3;
    const int vrow0 = 4 * g + vq;
    const int vsw = ((vrow0 >> 1) & 3) << 1;
    float m_run[NMAP], l_run[NMAP];
    f32x4 o[NMAP][4];
#pragma unroll
    for (int mp = 0; mp < NMAP; ++mp) { m_run[mp] = -1e30f; l_run[mp] = 0.f;
#pragma unroll
        for (int n = 0; n < 4; ++n) o[mp][n] = (f32x4){0.f, 0.f, 0.f, 0.f}; }
    const int wq = wv * 16 + c;
    const int na_cs = min(max(wq - 8, 0), 48);
    for (int t = 0; t < ntiles; ++t) {
        if (t + 1 < ntiles) AT_WRITE((t + 1) & 1);
        if (t + 2 < ntiles) AT_LOAD(t + 2);
        LAS const unsigned char* kb = lds + (t & 1) * AT_BUF + AT_K;
        LAS const unsigned char* rb = lds + (t & 1) * AT_BUF + AT_R;
        LAS const unsigned char* vb = lds + (t & 1) * AT_BUF + AT_V;
        bf16x8 pf[NMAP][2];
#pragma unroll
        for (int mp = 0; mp < NMAP; ++mp) {
            f32x4 s[4];
#pragma unroll
            for (int blk = 0; blk < 4; ++blk) {
                f32x4 a = (f32x4){0.f, 0.f, 0.f, 0.f};
                if (MODE == 0) {
                    const bf16x8 kf = *(LAS const bf16x8*)(kb + blk * 2048 + (mp == 0 ? koff0 : koff1));
                    a = __builtin_amdgcn_mfma_f32_16x16x32_bf16(kf, qf[mp][0], a, 0, 0, 0);
                } else {
                    const bf16x8 kf0 = *(LAS const bf16x8*)(kb + blk * 2048 + koff0), kf1 = *(LAS const bf16x8*)(kb + blk * 2048 + koff1);
                    a = __builtin_amdgcn_mfma_f32_16x16x32_bf16(kf0, qf[0][0], a, 0, 0, 0);
                    a = __builtin_amdgcn_mfma_f32_16x16x32_bf16(kf1, qf[0][1 % NKS], a, 0, 0, 0);
                    if (MODE == 1) { const bf16x8 kf2 = *(LAS const bf16x8*)(rb + blk * 1024 + roff); a = __builtin_amdgcn_mfma_f32_16x16x32_bf16(kf2, qf[0][2 % NKS], a, 0, 0, 0); }
                }
                s[blk] = a;
            }
            const bool loc_tile = na_loc && t >= 4;
            if (loc_tile) {
                const int dr = na_rs + (t - 4) - na_r + 7;
                LAS const float* brow = (LAS const float*)(lds + AT_RPB) + dr * 31;
#pragma unroll
                for (int blk = 0; blk < 4; ++blk)
#pragma unroll
                    for (int i = 0; i < 4; ++i) {
                        const int wk = 16 * blk + 4 * g + i;
                        const bool ok = (wk >= na_cs) && (wk < na_cs + 16);
                        const int idx = min(max(wk - wq + 15, 0), 30);
                        s[blk][i] = ok ? (s[blk][i] * c1 + brow[idx]) : -INFINITY;
                    }
            } else {
#pragma unroll
                for (int blk = 0; blk < 4; ++blk) s[blk] = s[blk] * c1;
            }
            float mx = fmaxf(fmaxf(fmaxf(s[0][0], s[0][1]), fmaxf(s[0][2], s[0][3])), fmaxf(fmaxf(s[1][0], s[1][1]), fmaxf(s[1][2], s[1][3])));
            mx = fmaxf(mx, fmaxf(fmaxf(fmaxf(s[2][0], s[2][1]), fmaxf(s[2][2], s[2][3])), fmaxf(fmaxf(s[3][0], s[3][1]), fmaxf(s[3][2], s[3][3]))));
            mx = fmaxf(mx, __shfl_xor(mx, 16)); mx = fmaxf(mx, __shfl_xor(mx, 32));
            const float mn = fmaxf(m_run[mp], mx), alpha = __builtin_amdgcn_exp2f(m_run[mp] - mn);
            m_run[mp] = mn;
            float ps = 0.f;
#pragma unroll
            for (int blk = 0; blk < 4; ++blk)
#pragma unroll
                for (int i = 0; i < 4; ++i) { const float e = __builtin_amdgcn_exp2f(s[blk][i] - mn); s[blk][i] = e; ps += e; }
            l_run[mp] = l_run[mp] * alpha + ps;
#pragma unroll
            for (int n = 0; n < 4; ++n) o[mp][n] = o[mp][n] * alpha;
#pragma unroll
            for (int sidx = 0; sidx < 2; ++sidx) {
                u32x4 w;
                w.x = cvt_pk_bf16(s[2 * sidx][0], s[2 * sidx][1]); w.y = cvt_pk_bf16(s[2 * sidx][2], s[2 * sidx][3]);
                w.z = cvt_pk_bf16(s[2 * sidx + 1][0], s[2 * sidx + 1][1]); w.w = cvt_pk_bf16(s[2 * sidx + 1][2], s[2 * sidx + 1][3]);
                pf[mp][sidx] = __builtin_bit_cast(bf16x8, w);
            }
        }
#pragma unroll
        for (int sidx = 0; sidx < 2; ++sidx)
#pragma unroll
            for (int n = 0; n < 4; ++n) {
                const int chunk = (2 * n + (vpp >> 1)) ^ vsw;
                LAS const unsigned char* va = vb + (32 * sidx + vrow0) * 128 + (chunk << 4) + (vpp & 1) * 8;
                const s16x4 lo = lds_tr16(va), hi = lds_tr16(va + 16 * 128);
                bf16x8 vf; vf[0] = lo[0]; vf[1] = lo[1]; vf[2] = lo[2]; vf[3] = lo[3]; vf[4] = hi[0]; vf[5] = hi[1]; vf[6] = hi[2]; vf[7] = hi[3];
#pragma unroll
                for (int mp = 0; mp < NMAP; ++mp) o[mp][n] = __builtin_amdgcn_mfma_f32_16x16x32_bf16(vf, pf[mp][sidx], o[mp][n], 0, 0, 0);
            }
        __syncthreads();
    }
#undef AT_LOAD
#undef AT_WRITE
    float inv[NMAP];
#pragma unroll
    for (int mp = 0; mp < NMAP; ++mp) { float lt = l_run[mp]; lt += __shfl_xor(lt, 16); lt += __shfl_xor(lt, 32); inv[mp] = 1.0f / lt; }
    bf16_t* mix = (bf16_t*)(ws + WS_MIX) + (size_t)qtok * 1024 + MODE * 256 + hh * 64;
    if (MODE == 0) {
        float e1 = 0.f, e2 = 0.f;
        for (int i = 0; i < 32; ++i) { e1 += p.in[I_LQ1][l * 32 + i] * p.in[I_LK1][l * 32 + i]; e2 += p.in[I_LQ2][l * 32 + i] * p.in[I_LK2][l * 32 + i]; }
        const float lam_init = 0.8f - 0.6f * expf(-0.3f * (float)l);
        const float lam = expf(e1) - expf(e2) + lam_init;
        f32x4 r[4]; float ss = 0.f;
#pragma unroll
        for (int n = 0; n < 4; ++n) { r[n] = o[0][n] * inv[0] - o[NMAP - 1][n] * (lam * inv[NMAP - 1]); ss += r[n][0] * r[n][0] + r[n][1] * r[n][1] + r[n][2] * r[n][2] + r[n][3] * r[n][3]; }
        ss += __shfl_xor(ss, 16); ss += __shfl_xor(ss, 32);
        const float rs = rsqrtf(ss * (1.0f / 64.0f) + EPS) * (1.0f - lam_init);
#pragma unroll
        for (int n = 0; n < 4; ++n) { const f32x4 gs = *(const f32x4*)(p.in[I_GSUB] + l * 64 + 16 * n + 4 * g); store_bf16x4(mix + 16 * n + 4 * g, r[n] * rs * gs); }
    } else {
#pragma unroll
        for (int n = 0; n < 4; ++n) store_bf16x4(mix + 16 * n + 4 * g, o[0][n] * inv[0]);
    }
}

constexpr int N_MIX_UNITS = 1792;
DI void conv_unit(const Params& p, int l, int cu, LAS unsigned char* lds);
DI void mixer_unit(const Params& p, int l, int u, LAS unsigned char* lds) {
    if (u < 768) {
        const int mode = u >> 8, r = u & 255, b = r >> 7, hh = (r >> 5) & 3, qb = r & 31;
        const int own0 = 4096 + b * 2048, q0 = own0 + qb * 64;
        if (mode == 0) attn_unit<0>(p, l, b, hh, true, q0, own0, 36, -1, lds);
        else if (mode == 1) attn_unit<1>(p, l, b, hh, true, q0, own0, 36, -1, lds);
        else attn_unit<2>(p, l, b, hh, true, q0, own0, 12, qb, lds);
    } else if (u < 1536) {
        const int v = u - 768, mode = v >> 8, r = v & 255, b = r >> 4, hh = (r >> 2) & 3, qb = r & 3;
        const int own0 = b * 256, q0 = own0 + qb * 64;
        if (mode == 0) attn_unit<0>(p, l, b, hh, false, q0, own0, 4, -1, lds);
        else if (mode == 1) attn_unit<1>(p, l, b, hh, false, q0, own0, 4, -1, lds);
        else attn_unit<2>(p, l, b, hh, false, q0, own0, 4, -1, lds);
    } else conv_unit(p, l, u - 1536, lds);
}

DI void conv_unit(const Params& p, int l, int cu, LAS unsigned char* lds) {
    const int tid = opaque_tid(), c = tid, wid = tid >> 6, lane = tid & 63;
    unsigned char* ws = p.ws;
    const int t0 = cu * 32;
    const bool lat = t0 >= 4096;
    const int seq0 = lat ? 4096 + ((t0 - 4096) >> 11) * 2048 : (t0 >> 8) * 256, seqlen = lat ? 2048 : 256;
    const bf16_t* CU = (const bf16_t*)(ws + WS_CU);
    float w[31];
#pragma unroll
    for (int j = 0; j < 31; ++j) w[j] = p.in[I_CDW][((size_t)l * 31 + j) * 256 + c];
    const float bias = p.in[I_CB][l * 256 + c];
    LAS float* y = (LAS float*)lds;
    __syncthreads();
#pragma unroll 1
    for (int half = 0; half < 2; ++half) {
        float g[46];
#pragma unroll
        for (int i = 0; i < 46; ++i) {
            const int s = t0 - seq0 + half * 16 + i - 15;
            float v = 0.f;
            if (s >= 0 && s < seqlen) { const size_t r = (size_t)(seq0 + s) * 512; const float a = bf2f(CU[r + c]), bb = bf2f(CU[r + 256 + c]); v = a / (1.f + __expf(-bb)); }
            g[i] = v;
        }
#pragma unroll
        for (int i = 0; i < 16; ++i) {
            float a = bias;
#pragma unroll
            for (int j = 0; j < 31; ++j) a += g[i + j] * w[j];
            y[(half * 16 + i) * 256 + c] = a;
        }
    }
    __syncthreads();
    const f32x4 lg = *(const f32x4*)(p.in[I_CLG] + l * 256 + lane * 4), lb = *(const f32x4*)(p.in[I_CLB] + l * 256 + lane * 4);
    for (int i = wid * 8; i < wid * 8 + 8; ++i) {
        f32x4 v = *(LAS const f32x4*)(y + i * 256 + lane * 4);
        const float mu = wave_sum(v[0] + v[1] + v[2] + v[3]) * (1.0f / 256.0f);
        const f32x4 d = v - mu;
        const float var = wave_sum(d[0] * d[0] + d[1] * d[1] + d[2] * d[2] + d[3] * d[3]) * (1.0f / 256.0f);
        const float rstd = rsqrtf(var + EPS);
        f32x4 o = d * rstd * lg + lb;
#pragma unroll
        for (int j = 0; j < 4; ++j) o[j] = o[j] / (1.f + __expf(-o[j]));
        store_bf16x4((bf16_t*)(ws + WS_MIX) + (size_t)(t0 + i) * 1024 + 768 + lane * 4, o);
    }
    __syncthreads();
}

#define XB_TMO      128
#define XB_XCNT(j)  (256  + 64 * (j))
#define XB_XSUB(j)  (1280 + 64 * (j))
#define XB_XGEN(j)  (2304 + 64 * (j))
#define XB_TOP      3328
#define XB_TOPGEN   3392
#define XCD_BAR_WORDS 3456
#define XB_SPIN_CAP (1u << 20)
DI unsigned xb_ld(unsigned* p) { return __hip_atomic_load(p, __ATOMIC_RELAXED, __HIP_MEMORY_SCOPE_AGENT); }
DI unsigned xb_add(unsigned* p, unsigned v) { return __hip_atomic_fetch_add(p, v, __ATOMIC_RELAXED, __HIP_MEMORY_SCOPE_AGENT); }
DI unsigned xb_xcc_id() { return (unsigned)__builtin_amdgcn_s_getreg((3 << 11) | 20) & 0xFu; }
#define XB_SPIN(cond, bar) do { unsigned _sp = 0; while (cond) { __builtin_amdgcn_s_sleep(1); \
    if ((++_sp & 255u) == 0u) { if (xb_ld(&(bar)[XB_TMO])) break; if (_sp > XB_SPIN_CAP) { atomicAdd(&(bar)[XB_TMO], 1u); break; } } } } while (0)
struct XcdBarrier { unsigned* bar; unsigned x; volatile LAS unsigned* st; };
DI XcdBarrier xcd_barrier_post(unsigned* bar, volatile LAS unsigned* st) {
    XcdBarrier b; b.bar = bar; b.x = xb_xcc_id(); b.st = st;
    if (threadIdx.x == 0) (void)xb_add(&bar[XB_XCNT(b.x)], 1u);
    return b;
}
DI void xcd_barrier_complete(unsigned* bar, unsigned x, unsigned& nloc, unsigned& nx) {
    const unsigned G = gridDim.x;
    unsigned sum, cnt, mine, sp = 0u;
    for (;;) {
        sum = 0u; cnt = 0u; mine = 0u;
#pragma unroll
        for (unsigned j = 0; j < 16; ++j) { const unsigned c = xb_ld(&bar[XB_XCNT(j)]); sum += c; cnt += (c > 0u) ? 1u : 0u; mine = (j == x) ? c : mine; }
        if (sum == G) break;
        __builtin_amdgcn_s_sleep(1);
        if ((++sp & 255u) == 0u) { if (xb_ld(&bar[XB_TMO])) break; if (sp > XB_SPIN_CAP) { atomicAdd(&bar[XB_TMO], 1u); break; } }
    }
    nloc = mine > 0u ? mine : 1u; nx = cnt > 0u ? cnt : 1u;
}
DI void xcd_barrier(const XcdBarrier& b) {
    asm volatile("s_waitcnt vmcnt(0)" ::: "memory");
    __syncthreads();
    if (threadIdx.x == 0) {
        unsigned* bar = b.bar;
        __builtin_amdgcn_s_waitcnt(0);
        unsigned nloc = b.st[0], nx = b.st[1];
        if (nloc == 0u) { xcd_barrier_complete(bar, b.x, nloc, nx); b.st[0] = nloc; b.st[1] = nx; }
        const unsigned old = xb_add(&bar[XB_XSUB(b.x)], 1u);
        const unsigned gen = old / nloc;
        if (old + 1u == (gen + 1u) * nloc) {
            __builtin_amdgcn_fence(__ATOMIC_RELEASE, "agent");
            asm volatile("s_waitcnt vmcnt(0)" ::: "memory");
            const unsigned og = xb_add(&bar[XB_TOP], 1u);
            const unsigned tg = og / nx;
            if (og + 1u == (tg + 1u) * nx) xb_add(&bar[XB_TOPGEN], 1u);
            else XB_SPIN(xb_ld(&bar[XB_TOPGEN]) == tg, bar);
            __builtin_amdgcn_fence(__ATOMIC_ACQUIRE, "agent");
            xb_add(&bar[XB_XGEN(b.x)], 1u);
            asm volatile("s_waitcnt vmcnt(0)" ::: "memory");
        } else {
            XB_SPIN(xb_ld(&bar[XB_XGEN(b.x)]) == gen, bar);
            __builtin_amdgcn_fence(__ATOMIC_ACQUIRE, "agent");
            asm volatile("s_waitcnt vmcnt(0)" ::: "memory");
        }
    }
    __syncthreads();
}

constexpr int N_PHASES = 18;
typedef const unsigned char __attribute__((address_space(4)))* kaptr_t;
#define FRESH_PARAMS(pp) kaptr_t ka_ = (kaptr_t)__builtin_amdgcn_kernarg_segment_ptr(); asm volatile("" : "+s"(ka_)); const Params& pp = *(const Params*)ka_

__global__ void __launch_bounds__(256, 2) mk_fwd(Params p_, int ph_lo, int ph_hi) {
    extern __shared__ __attribute__((aligned(16))) unsigned char smem[];
    LAS unsigned char* lds = (LAS unsigned char*)smem;
    const int G = gridDim.x, bid = blockIdx.x;
    volatile LAS unsigned* bst = (volatile LAS unsigned*)(lds + 65536);
    XcdBarrier xb;
    const bool multi = (ph_hi - ph_lo) > 1;
    if (multi) {
        if (threadIdx.x == 0) { bst[0] = 0u; bst[1] = 0u; }
        __syncthreads();
        xb = xcd_barrier_post((unsigned*)(p_.ws + WS_BAR), bst);
    }
    for (int ph = ph_lo; ph < ph_hi; ++ph) {
        if (ph == 0) {
            for (int u = bid; u < N_PRO_UNITS; u += G) { FRESH_PARAMS(p); prologue_unit(p, u, lds); }
        } else if (ph == 17) {
            for (int u = bid; u < NTOK / 4; u += G) { FRESH_PARAMS(p); final_norm_rows(p, u); }
        } else {
            const int l = (ph - 1) >> 3, sub = (ph - 1) & 7;
            if (sub == 0) { for (int u = bid; u < NTOK / 4; u += G) { FRESH_PARAMS(p); norm_rows(p, l, 0, u, l == 0); } }
            else if (sub == 5) { for (int u = bid; u < NTOK / 4; u += G) { FRESH_PARAMS(p); norm_rows(p, l, 1, u, false); } }
            else if (sub == 1) {
                for (int u = bid; u < 64 * 20; u += G) { FRESH_PARAMS(p); const int tm = u / 20, tn = u % 20; f32x4 acc[4][4];
                    gemm_tile((const bf16_t*)(p.ws + WS_H), (const bf16_t*)(p.ws + WS_WTIN) + (size_t)l * NIN * 1024, 1024, tm * 128, tn * 128, lds, acc); epi_inproj(p, l, acc, tm, tn, lds); }
            } else if (sub == 2) {
                for (int u = bid; u < 64 * 3 + 68 * 4; u += G) { FRESH_PARAMS(p);
                    f32x4 acc[4][4];
                    if (u < 192) { const int tm = u / 3, tn = u % 3; gemm_tile((const bf16_t*)(p.ws + WS_QD), (const bf16_t*)(p.ws + WS_WTQUP) + (size_t)l * 384 * 256, 256, tm * 128, tn * 128, lds, acc); epi_qup(p, acc, tm, tn); }
                    else { const int v = u - 192, tm = v / 4, tn = v % 4; gemm_tile((const bf16_t*)(p.ws + WS_CKVA) + (size_t)l * 8704 * 128, (const bf16_t*)(p.ws + WS_WTKV) + (size_t)l * 512 * 128, 128, tm * 128, tn * 128, lds, acc); epi_kvup(p, acc, tm, tn); }
                }
            } else if (sub == 3) {
                for (int u = bid; u < N_MIX_UNITS; u += G) { FRESH_PARAMS(p); mixer_unit(p, l, u, lds); }
            } else if (sub == 4) {
                for (int u = bid; u < 64 * 8; u += G) { FRESH_PARAMS(p); const int tm = u / 8, tn = u % 8; f32x4 acc[4][4];
                    gemm_tile((const bf16_t*)(p.ws + WS_MIX), (const bf16_t*)(p.ws + WS_WTOUT) + (size_t)l * 1024 * 1024, 1024, tm * 128, tn * 128, lds, acc); epi_resid(p, l, acc, tm, tn, 2, l == 0); }
            } else if (sub == 6) {
                for (int u = bid; u < 64 * 32; u += G) { FRESH_PARAMS(p); const int tm = u / 32, tn = u % 32; f32x4 acc[4][4];
                    gemm_tile((const bf16_t*)(p.ws + WS_H), (const bf16_t*)(p.ws + WS_WTFF1) + (size_t)l * 4096 * 1024, 1024, tm * 128, tn * 128, lds, acc); epi_ff1(p, acc, tm, tn); }
            } else {
                for (int u = bid; u < 64 * 8; u += G) { FRESH_PARAMS(p); const int tm = u / 8, tn = u % 8; f32x4 acc[4][4];
                    gemm_tile((const bf16_t*)(p.ws + WS_HBUF), (const bf16_t*)(p.ws + WS_WTFF2) + (size_t)l * 1024 * 4096, 4096, tm * 128, tn * 128, lds, acc); epi_resid(p, l, acc, tm, tn, 5, false); }
            }
        }
        if (multi && ph + 1 < ph_hi) xcd_barrier(xb);
    }
}

#ifndef MK_ONE_LAUNCH
#define MK_ONE_LAUNCH 1
#endif
extern "C" void kernel_launch(void* const* d_in, const int* in_sizes, int n_in, void* d_out, int out_size, void* d_ws, size_t ws_size, hipStream_t stream) {
    static int grid = 0;
    if (grid == 0) {
        if (n_in != N_IN || ws_size < WS_END) { fprintf(stderr, "kernel_launch: unexpected n_in %d / ws_size %zu (need %zu)\n", n_in, ws_size, (size_t)WS_END); grid = -1; return; }
        if (hipFuncSetAttribute((const void*)mk_fwd, hipFuncAttributeMaxDynamicSharedMemorySize, LDS_BYTES) != hipSuccess) { fprintf(stderr, "kernel_launch: hipFuncSetAttribute failed\n"); grid = -1; return; }
        int dev = 0, cus = 0, per_cu = 0;
        (void)hipGetDevice(&dev); (void)hipDeviceGetAttribute(&cus, hipDeviceAttributeMultiprocessorCount, dev);
        if (hipOccupancyMaxActiveBlocksPerMultiprocessor(&per_cu, (const void*)mk_fwd, 256, LDS_BYTES) != hipSuccess || per_cu < 1) per_cu = 1;
        if (per_cu > 2) per_cu = 2;
        grid = cus * per_cu;
        fprintf(stderr, "kernel_launch: %d CUs x %d blocks\n", cus, per_cu);
    }
    if (grid < 0) return;
    Params p{};
    for (int i = 0; i < N_IN; ++i) p.in[i] = (const float*)d_in[i];
    p.out = (float*)d_out; p.ws = (unsigned char*)d_ws;
#if MK_ONE_LAUNCH
    (void)hipMemsetAsync((unsigned char*)d_ws + WS_BAR, 0, XCD_BAR_WORDS * 4, stream);
    int lo = 0, hi = N_PHASES;
    void* args[] = {&p, &lo, &hi};
    hipError_t e = hipLaunchCooperativeKernel((const void*)mk_fwd, dim3(grid), dim3(256), args, LDS_BYTES, stream);
    if (e != hipSuccess) fprintf(stderr, "cooperative launch failed: %s (grid %d)\n", hipGetErrorString(e), grid);
#else
    for (int ph = 0; ph < N_PHASES; ++ph) hipLaunchKernelGGL(mk_fwd, dim3(grid), dim3(256), LDS_BYTES, stream, p, ph, ph + 1);
#endif
}
```

```cpp
#include <hip/hip_runtime.h>
#include <cstdint>
#include <cstdio>

typedef unsigned short bf16_t;
typedef short bf16x8 __attribute__((ext_vector_type(8)));
typedef float f32x4 __attribute__((ext_vector_type(4)));
typedef unsigned u32x2 __attribute__((ext_vector_type(2)));
typedef unsigned u32x4 __attribute__((ext_vector_type(4)));
#define LAS __attribute__((address_space(3)))
#define DI __device__ __forceinline__

constexpr int DM = 1024, NTOK = 8192, NCTXTOK = 4096, NLAYER = 2;
constexpr int NIN = 2560;
constexpr int DFF = 4096;
constexpr float EPS = 1e-6f;
enum { I_XP = 0, I_XS, I_C, I_CDAK, I_CDAV, I_CCKV, I_CKR, I_CNAK, I_CNAV, I_CCTX, I_WMOD, I_BMOD, I_GMIX, I_GFF, I_WIN,
       I_LQ1, I_LK1, I_LQ2, I_LK2, I_GSUB, I_GMQ, I_WQUP, I_GMKV, I_WKVUP, I_RPB, I_CDW, I_CB, I_CLG, I_CLB, I_WOUT, I_WFF1, I_WFF2, I_GFIN, N_IN };
constexpr size_t O_YP = 0, O_YS = 4194304, O_DAK = 8388608, O_DAV = 10485760, O_CKV = 12582912, O_KR = 13631488, O_NAK = 13893632, O_NAV = 15990784;

constexpr size_t al256(size_t x) { return (x + 255) & ~(size_t)255; }
constexpr size_t WS_BAR   = 0;
constexpr size_t WS_WTIN  = 16384;
constexpr size_t WS_WTQUP = WS_WTIN  + (size_t)NLAYER * NIN * 1024 * 2;
constexpr size_t WS_WTKV  = WS_WTQUP + (size_t)NLAYER * 384 * 256 * 2;
constexpr size_t WS_WTOUT = WS_WTKV  + (size_t)NLAYER * 512 * 128 * 2;
constexpr size_t WS_WTFF1 = WS_WTOUT + (size_t)NLAYER * 1024 * 1024 * 2;
constexpr size_t WS_WTFF2 = WS_WTFF1 + (size_t)NLAYER * 4096 * 1024 * 2;
constexpr size_t WS_MOD   = WS_WTFF2 + (size_t)NLAYER * 1024 * 4096 * 2;
constexpr size_t WS_ROPE  = WS_MOD   + (size_t)NLAYER * 3 * 6144 * 4;
constexpr size_t WS_H     = WS_ROPE  + 4096;
constexpr size_t WS_QDA   = WS_H     + (size_t)NTOK * 1024 * 2;
constexpr size_t WS_KDA   = WS_QDA   + (size_t)NTOK * 256 * 2;
constexpr size_t WS_VDA   = WS_KDA   + (size_t)NTOK * 256 * 2;
constexpr size_t WS_QNA   = WS_VDA   + (size_t)NTOK * 256 * 2;
constexpr size_t WS_KNA   = WS_QNA   + (size_t)NTOK * 256 * 2;
constexpr size_t WS_VNA   = WS_KNA   + (size_t)NTOK * 256 * 2;
constexpr size_t WS_QD    = WS_VNA   + (size_t)NTOK * 256 * 2;
constexpr size_t WS_SSQQ  = WS_QD    + (size_t)NTOK * 256 * 2;
constexpr size_t WS_CKVA  = WS_SSQQ  + (size_t)NTOK * 4 * 4;
constexpr size_t WS_KRA   = WS_CKVA  + (size_t)NLAYER * 8704 * 128 * 2;
constexpr size_t WS_KRC   = WS_KRA   + (size_t)NTOK * 32 * 2;
constexpr size_t WS_QM    = WS_KRC   + (size_t)NLAYER * 2 * 256 * 32 * 2;
constexpr size_t WS_KVM   = WS_QM    + (size_t)NTOK * 384 * 2;
constexpr size_t WS_KCDA  = WS_KVM   + (size_t)8704 * 512 * 2;
constexpr size_t WS_VCDA  = WS_KCDA  + (size_t)NLAYER * 2 * 4 * 256 * 64 * 2;
constexpr size_t WS_KCNA  = WS_VCDA  + (size_t)NLAYER * 2 * 4 * 256 * 64 * 2;
constexpr size_t WS_VCNA  = WS_KCNA  + (size_t)NLAYER * 2 * 4 * 256 * 64 * 2;
constexpr size_t WS_CU    = WS_VCNA  + (size_t)NLAYER * 2 * 4 * 256 * 64 * 2;
constexpr size_t WS_MIX   = WS_CU    + (size_t)NTOK * 512 * 2;
constexpr size_t WS_XRES  = WS_MIX   + (size_t)NTOK * 1024 * 2;
constexpr size_t WS_HBUF  = WS_XRES  + (size_t)NTOK * 1024 * 4;
constexpr size_t WS_END   = WS_HBUF  + (size_t)NTOK * 4096 * 2;

struct Params {
    const float* in[N_IN];
    float* out;
    unsigned char* ws;
};

constexpr int LDS_BYTES = 65536 + 64;

typedef float f32x2 __attribute__((ext_vector_type(2)));
typedef __bf16 bf16x2v __attribute__((ext_vector_type(2)));
DI unsigned cvt_pk_bf16(float lo, float hi) { f32x2 v = {lo, hi}; return __builtin_bit_cast(unsigned, __builtin_convertvector(v, bf16x2v)); }
DI bf16_t f2bf(float x) { unsigned u = __float_as_uint(x); u += 0x7fffu + ((u >> 16) & 1u); return (bf16_t)(u >> 16); }
DI float bf2f(bf16_t v) { return __uint_as_float(((unsigned)v) << 16); }
DI int opaque_tid() { int t = threadIdx.x; asm volatile("" : "+v"(t)); return t; }
DI float wave_sum(float v) {
#pragma unroll
    for (int o = 32; o > 0; o >>= 1) v += __shfl_xor(v, o);
    return v;
}
DI int seg_of_row(int row) { return row < 4096 ? 0 : (row < 6144 ? 1 : 2); }
DI const float* x_in_row(const Params& p, int row) { return row < 4096 ? p.in[I_XP] + (size_t)row * 1024 : p.in[I_XS] + (size_t)(row - 4096) * 1024; }

DI void gemm_stage(const bf16_t* __restrict__ A, const bf16_t* __restrict__ Bt, int K, int row0, int col0, int k0, LAS unsigned char* lds_stage, int tid) {
#pragma unroll
    for (int i = 0; i < 4; ++i) {
        const int b = i * 4096 + tid * 16, row = b >> 7, pch = (b >> 4) & 7, lch = pch ^ ((row >> 1) & 7);
        const bf16_t* ga = A + (size_t)(row0 + row) * K + k0 + lch * 8;
        const bf16_t* gb = Bt + (size_t)(col0 + row) * K + k0 + lch * 8;
        __builtin_amdgcn_global_load_lds((const unsigned*)ga, (LAS unsigned*)(lds_stage + b), 16, 0, 0);
        __builtin_amdgcn_global_load_lds((const unsigned*)gb, (LAS unsigned*)(lds_stage + 16384 + b), 16, 0, 0);
    }
}

DI void gemm_tile(const bf16_t* __restrict__ A, const bf16_t* __restrict__ Bt, int K, int row0, int col0, LAS unsigned char* lds, f32x4 (&acc)[4][4]) {
    const int tid = opaque_tid(), wid = tid >> 6, lane = tid & 63, wr = wid >> 1, wc = wid & 1, fr = lane & 15, fq = lane >> 4;
#pragma unroll
    for (int m = 0; m < 4; ++m)
#pragma unroll
        for (int n = 0; n < 4; ++n) acc[m][n] = (f32x4){0.f, 0.f, 0.f, 0.f};
    const int sw = (fr >> 1) & 7;
    const int offk0 = ((0 + fq) ^ sw) << 4, offk1 = ((4 + fq) ^ sw) << 4;
    const int abase = (wr * 64 + fr) * 128, bbase = 16384 + (wc * 64 + fr) * 128;
    const int nt = K >> 6;
    __syncthreads();
    gemm_stage(A, Bt, K, row0, col0, 0, lds, tid);
    for (int t = 0; t < nt; ++t) {
        asm volatile("s_waitcnt vmcnt(0)" ::: "memory");
        __syncthreads();
        if (t + 1 < nt) gemm_stage(A, Bt, K, row0, col0, (t + 1) << 6, lds + ((t + 1) & 1) * 32768, tid);
        LAS const unsigned char* st = lds + (t & 1) * 32768;
        bf16x8 af[4][2], bfr[4][2];
#pragma unroll
        for (int m = 0; m < 4; ++m) {
            af[m][0] = *(LAS const bf16x8*)(st + abase + m * 2048 + offk0);
            af[m][1] = *(LAS const bf16x8*)(st + abase + m * 2048 + offk1);
        }
#pragma unroll
        for (int n = 0; n < 4; ++n) {
            bfr[n][0] = *(LAS const bf16x8*)(st + bbase + n * 2048 + offk0);
            bfr[n][1] = *(LAS const bf16x8*)(st + bbase + n * 2048 + offk1);
        }
#pragma unroll
        for (int k = 0; k < 2; ++k)
#pragma unroll
            for (int m = 0; m < 4; ++m)
#pragma unroll
                for (int n = 0; n < 4; ++n)
                    acc[m][n] = __builtin_amdgcn_mfma_f32_16x16x32_bf16(bfr[n][k], af[m][k], acc[m][n], 0, 0, 0);
    }
}


DI void tile_of_unit(int L, int nunits, int G, int nN, int nM, int& tm, int& tn) {
    const int k = L / G, base = k * G, R = min(G, nunits - base), i = L - base;
    const int xcd = i & 7, off = i >> 3, q = R >> 3, r = R & 7;
    const int w = base + (xcd < r ? xcd * (q + 1) : r * (q + 1) + (xcd - r) * q) + off;
    const int nig = 8 * nN, gid = w / nig, fm = gid * 8, gsz = min(nM - fm, 8), wi = w - gid * nig;
    tm = fm + (wi % gsz); tn = wi / gsz;
}

DI f32x4 rope4(f32x4 v, const float* __restrict__ ropetab, int pos, int fq) {
    const f32x4 cs = *(const f32x4*)(ropetab + pos * 8 + 4 * (fq & 1));
    const f32x4 sn = *(const f32x4*)(ropetab + 512 + pos * 8 + 4 * (fq & 1));
    f32x4 o;
#pragma unroll
    for (int j = 0; j < 4; ++j) {
        const float pr = __shfl_xor(v[j], 32);
        o[j] = (fq >= 2) ? (pr * sn[j] + v[j] * cs[j]) : (v[j] * cs[j] - pr * sn[j]);
    }
    return o;
}
DI void store_bf16x4(bf16_t* dst, f32x4 v) { u32x2 w; w.x = cvt_pk_bf16(v[0], v[1]); w.y = cvt_pk_bf16(v[2], v[3]); *(u32x2*)dst = w; }

DI void epi_inproj(const Params& p, int l, f32x4 (&acc)[4][4], int tm, int tn, LAS unsigned char* lds) {
    const int tid = opaque_tid(), wid = tid >> 6, lane = tid & 63, wr = wid >> 1, wc = wid & 1, fr = lane & 15, fq = lane >> 4;
    unsigned char* ws = p.ws;
    const bool lat = tm >= 32;
    const float* ropetab = (const float*)(ws + WS_ROPE);
    float* out = p.out;
    if (tn == 8) {
        LAS float* ex = (LAS float*)lds;
        __syncthreads();
#pragma unroll
        for (int m = 0; m < 4; ++m) {
            float s = 0.f;
#pragma unroll
            for (int n = 0; n < 4; ++n)
#pragma unroll
                for (int j = 0; j < 4; ++j) s += acc[m][n][j] * acc[m][n][j];
            s += __shfl_xor(s, 16); s += __shfl_xor(s, 32);
            if (fq == 0) ex[(wr * 64 + m * 16 + fr) * 2 + wc] = s;
        }
        __syncthreads();
        const float* gkv = p.in[I_GMKV] + l * 128;
        bf16_t* ckva = (bf16_t*)(ws + WS_CKVA) + (size_t)l * 8704 * 128;
#pragma unroll
        for (int m = 0; m < 4; ++m) {
            const int rl = wr * 64 + m * 16 + fr, row = tm * 128 + rl;
            const float rstd = rsqrtf((ex[rl * 2] + ex[rl * 2 + 1]) * (1.0f / 128.0f) + EPS);
#pragma unroll
            for (int n = 0; n < 4; ++n) {
                const int col = wc * 64 + n * 16 + 4 * fq;
                const f32x4 g = *(const f32x4*)(gkv + col);
                f32x4 v = acc[m][n] * rstd * g;
                store_bf16x4(ckva + (size_t)row * 128 + col, v);
                if (!lat) { const int b = row >> 8, s = row & 255; *(f32x4*)(out + O_CKV + ((size_t)(b * 2 + l) * 256 + s) * 128 + col) = v; }
            }
        }
        __syncthreads();
        return;
    }
#pragma unroll
    for (int m = 0; m < 4; ++m) {
        const int row = tm * 128 + wr * 64 + m * 16 + fr;
        const int sl = (row - 4096) & 2047, prow = sl >> 6, pcol = sl & 63;
        const int cb = row >> 8, cs = row & 255;
        if (tn == 6 || tn == 7) {
            float s = 0.f;
#pragma unroll
            for (int n = 0; n < 4; ++n)
#pragma unroll
                for (int j = 0; j < 4; ++j) s += acc[m][n][j] * acc[m][n][j];
            s += __shfl_xor(s, 16); s += __shfl_xor(s, 32);
            if (fq == 0) ((float*)(ws + WS_SSQQ))[row * 4 + (tn - 6) * 2 + wc] = s;
        }
#pragma unroll
        for (int n = 0; n < 4; ++n) {
            const int cw = wc * 64 + n * 16 + 4 * fq;
            f32x4 v = acc[m][n];
            if (tn < 2) {
                if (lat) v = rope4(v, ropetab, (n & 1) ? pcol : prow, fq);
                store_bf16x4((bf16_t*)(ws + WS_QDA) + (size_t)row * 256 + tn * 128 + cw, v);
            } else if (tn < 4) {
                if (lat) v = rope4(v, ropetab, (n & 1) ? pcol : prow, fq);
                const int c = (tn - 2) * 128 + cw;
                store_bf16x4((bf16_t*)(ws + WS_KDA) + (size_t)row * 256 + c, v);
                if (!lat) *(f32x4*)(out + O_DAK + (((size_t)(cb * 2 + l) * 4 + (c >> 6)) * 256 + cs) * 64 + (c & 63)) = v;
            } else if (tn < 6) {
                const int c = (tn - 4) * 128 + cw;
                store_bf16x4((bf16_t*)(ws + WS_VDA) + (size_t)row * 256 + c, v);
                if (!lat) *(f32x4*)(out + O_DAV + (((size_t)(cb * 2 + l) * 4 + (c >> 6)) * 256 + cs) * 64 + (c & 63)) = v;
            } else if (tn < 8) {
                store_bf16x4((bf16_t*)(ws + WS_QD) + (size_t)row * 256 + (tn - 6) * 128 + cw, v);
            } else if (tn < 11) {
                store_bf16x4((bf16_t*)(ws + WS_QNA) + (size_t)row * 256 + (tn - 9) * 128 + cw, v);
            } else if (tn < 13) {
                const int c = (tn - 11) * 128 + cw;
                store_bf16x4((bf16_t*)(ws + WS_KNA) + (size_t)row * 256 + c, v);
                if (!lat) *(f32x4*)(out + O_NAK + (((size_t)(cb * 2 + l) * 4 + (c >> 6)) * 256 + cs) * 64 + (c & 63)) = v;
            } else if (tn < 15) {
                const int c = (tn - 13) * 128 + cw;
                store_bf16x4((bf16_t*)(ws + WS_VNA) + (size_t)row * 256 + c, v);
                if (!lat) *(f32x4*)(out + O_NAV + (((size_t)(cb * 2 + l) * 4 + (c >> 6)) * 256 + cs) * 64 + (c & 63)) = v;
            } else if (tn < 19) {
                store_bf16x4((bf16_t*)(ws + WS_CU) + (size_t)row * 512 + (tn - 15) * 128 + cw, v);
            } else {
                if (lat) v = rope4(v, ropetab, (n & 1) ? pcol : prow, fq);
                if (wc == 0 && n < 2) {
                    store_bf16x4((bf16_t*)(ws + WS_KRA) + (size_t)row * 32 + cw, v);
                    if (!lat) *(f32x4*)(out + O_KR + ((size_t)(cb * 2 + l) * 256 + cs) * 32 + cw) = v;
                }
            }
        }
    }
}

DI void epi_qup(const Params& p, f32x4 (&acc)[4][4], int tm, int tn) {
    const int tid = opaque_tid(), wid = tid >> 6, lane = tid & 63, wr = wid >> 1, wc = wid & 1, fr = lane & 15, fq = lane >> 4;
    unsigned char* ws = p.ws;
    const bool lat = tm >= 32;
    const float* ropetab = (const float*)(ws + WS_ROPE);
#pragma unroll
    for (int m = 0; m < 4; ++m) {
        const int row = tm * 128 + wr * 64 + m * 16 + fr;
        const int sl = (row - 4096) & 2047, prow = sl >> 6, pcol = sl & 63;
        const f32x4 sq = *(const f32x4*)((const float*)(ws + WS_SSQQ) + row * 4);
        const float rstd = rsqrtf((sq[0] + sq[1] + sq[2] + sq[3]) * (1.0f / 256.0f) + EPS);
#pragma unroll
        for (int n = 0; n < 4; ++n) {
            f32x4 v = acc[m][n] * rstd;
            if (tn == 2 && lat) v = rope4(v, ropetab, (n & 1) ? pcol : prow, fq);
            store_bf16x4((bf16_t*)(ws + WS_QM) + (size_t)row * 384 + tn * 128 + wc * 64 + n * 16 + 4 * fq, v);
        }
    }
}
DI void epi_kvup(const Params& p, f32x4 (&acc)[4][4], int tm, int tn) {
    const int tid = opaque_tid(), wid = tid >> 6, lane = tid & 63, wr = wid >> 1, wc = wid & 1, fr = lane & 15, fq = lane >> 4;
#pragma unroll
    for (int m = 0; m < 4; ++m) {
        const int row = tm * 128 + wr * 64 + m * 16 + fr;
#pragma unroll
        for (int n = 0; n < 4; ++n) store_bf16x4((bf16_t*)(p.ws + WS_KVM) + (size_t)row * 512 + tn * 128 + wc * 64 + n * 16 + 4 * fq, acc[m][n]);
    }
}
DI void epi_resid(const Params& p, int l, f32x4 (&acc)[4][4], int tm, int tn, int gi, bool from_input) {
    const int tid = opaque_tid(), wid = tid >> 6, lane = tid & 63, wr = wid >> 1, wc = wid & 1, fr = lane & 15, fq = lane >> 4;
    float* xres = (float*)(p.ws + WS_XRES);
    const int seg = seg_of_row(tm * 128);
    const float* gate = (const float*)(p.ws + WS_MOD) + ((size_t)l * 3 + seg) * 6144 + gi * 1024;
#pragma unroll
    for (int m = 0; m < 4; ++m) {
        const int row = tm * 128 + wr * 64 + m * 16 + fr;
        const float* src = from_input ? x_in_row(p, row) : xres + (size_t)row * 1024;
#pragma unroll
        for (int n = 0; n < 4; ++n) {
            const int col = tn * 128 + wc * 64 + n * 16 + 4 * fq;
            const f32x4 g = *(const f32x4*)(gate + col);
            const f32x4 xv = *(const f32x4*)(src + col);
            *(f32x4*)(xres + (size_t)row * 1024 + col) = xv + g * acc[m][n];
        }
    }
}
DI void epi_ff1(const Params& p, f32x4 (&acc)[4][4], int tm, int tn) {
    const int tid = opaque_tid(), wid = tid >> 6, lane = tid & 63, wr = wid >> 1, wc = wid & 1, fr = lane & 15, fq = lane >> 4;
#pragma unroll
    for (int m = 0; m < 4; ++m) {
        const int row = tm * 128 + wr * 64 + m * 16 + fr;
#pragma unroll
        for (int n = 0; n < 4; ++n) {
            f32x4 v = acc[m][n];
#pragma unroll
            for (int j = 0; j < 4; ++j) { const float r = fmaxf(v[j], 0.f); v[j] = r * r; }
            store_bf16x4((bf16_t*)(p.ws + WS_HBUF) + (size_t)row * 4096 + tn * 128 + wc * 64 + n * 16 + 4 * fq, v);
        }
    }
}

DI void transpose_tile(const float* __restrict__ src, int ld_src, bf16_t* __restrict__ dst, int K, int k0, int n0, int mode, const float* __restrict__ kscale, LAS float* t) {
    const int tid = opaque_tid(), ty = tid >> 4, tx = tid & 15;
    const int nd = n0 + 4 * tx;
    int sc;
    if (mode == 0) {
        if (nd < 1152) sc = nd; else if (nd < 2432) sc = nd + 32; else if (nd < 2464) sc = nd - 2432 + 1152; else sc = -1;
    } else if (mode == 1) {
        if (nd < 256) sc = (nd >> 6) * 96 + (nd & 63); else { const int r = nd - 256; sc = (r >> 5) * 96 + 64 + (r & 31); }
    } else sc = nd;
    __syncthreads();
#pragma unroll
    for (int i = 0; i < 4; ++i) {
        const int kk = ty + 16 * i;
        f32x4 v = (f32x4){0.f, 0.f, 0.f, 0.f};
        if (sc >= 0) v = *(const f32x4*)(src + (size_t)(k0 + kk) * ld_src + sc);
        if (kscale) v = v * kscale[k0 + kk];
        t[kk * 65 + 4 * tx + 0] = v[0]; t[kk * 65 + 4 * tx + 1] = v[1]; t[kk * 65 + 4 * tx + 2] = v[2]; t[kk * 65 + 4 * tx + 3] = v[3];
    }
    __syncthreads();
    const int nn = tid >> 2, kc = tid & 3;
    unsigned w[8];
#pragma unroll
    for (int e = 0; e < 8; ++e) w[e] = cvt_pk_bf16(t[(kc * 16 + 2 * e) * 65 + nn], t[(kc * 16 + 2 * e + 1) * 65 + nn]);
    bf16_t* d = dst + (size_t)(n0 + nn) * K + k0 + kc * 16;
    *(u32x4*)d = (u32x4){w[0], w[1], w[2], w[3]};
    *(u32x4*)(d + 8) = (u32x4){w[4], w[5], w[6], w[7]};
}

constexpr int TR_PER_LAYER = 640 + 24 + 16 + 256 + 1024 + 1024;
constexpr int N_TR = NLAYER * TR_PER_LAYER;
constexpr int N_MODU = NLAYER * 48 * 2;
constexpr int N_CACHE_ELEMS = NLAYER * 2 * (4 * 256 * 64 * 4 + 256 * 128 + 256 * 32);
constexpr int N_CACHEU = (N_CACHE_ELEMS / 4 + 255) / 256;

DI void prologue_unit(const Params& p, int u, LAS unsigned char* lds) {
    unsigned char* ws = p.ws;
    const int tid = opaque_tid();
    if (u < N_TR) {
        const int l = u / TR_PER_LAYER; int r = u % TR_PER_LAYER;
        LAS float* t = (LAS float*)lds;
        if (r < 640) { transpose_tile(p.in[I_WIN] + (size_t)l * 1024 * 2464, 2464, (bf16_t*)(ws + WS_WTIN) + (size_t)l * NIN * 1024, 1024, (r / 40) * 64, (r % 40) * 64, 0, nullptr, t); return; }
        r -= 640;
        if (r < 24) { transpose_tile(p.in[I_WQUP] + (size_t)l * 256 * 384, 384, (bf16_t*)(ws + WS_WTQUP) + (size_t)l * 384 * 256, 256, (r / 6) * 64, (r % 6) * 64, 1, p.in[I_GMQ] + l * 256, t); return; }
        r -= 24;
        if (r < 16) { transpose_tile(p.in[I_WKVUP] + (size_t)l * 128 * 512, 512, (bf16_t*)(ws + WS_WTKV) + (size_t)l * 512 * 128, 128, (r / 8) * 64, (r % 8) * 64, 2, nullptr, t); return; }
        r -= 16;
        if (r < 256) { transpose_tile(p.in[I_WOUT] + (size_t)l * 1024 * 1024, 1024, (bf16_t*)(ws + WS_WTOUT) + (size_t)l * 1024 * 1024, 1024, (r / 16) * 64, (r % 16) * 64, 2, nullptr, t); return; }
        r -= 256;
        if (r < 1024) { transpose_tile(p.in[I_WFF1] + (size_t)l * 1024 * 4096, 4096, (bf16_t*)(ws + WS_WTFF1) + (size_t)l * 4096 * 1024, 1024, (r / 64) * 64, (r % 64) * 64, 2, nullptr, t); return; }
        r -= 1024;
        transpose_tile(p.in[I_WFF2] + (size_t)l * 4096 * 1024, 1024, (bf16_t*)(ws + WS_WTFF2) + (size_t)l * 1024 * 4096, 4096, (r / 16) * 64, (r % 16) * 64, 2, nullptr, t);
        return;
    }
    u -= N_TR;
    if (u < N_MODU) {
        const int l = u / 96, cchunk = u % 96;
        const int cg = tid & 15, ks = tid >> 4;
        const int col = cchunk * 64 + cg * 4;
        const float* wm = p.in[I_WMOD] + (size_t)l * 1024 * 6144;
        f32x4 a0 = (f32x4){0.f, 0.f, 0.f, 0.f}, a1 = a0, a2 = a0;
        for (int k = ks * 64; k < ks * 64 + 64; ++k) {
            const f32x4 w = *(const f32x4*)(wm + (size_t)k * 6144 + col);
            float c0 = p.in[I_CCTX][k], c1 = p.in[I_C][k], c2 = p.in[I_C][1024 + k];
            c0 = c0 / (1.f + __expf(-c0)); c1 = c1 / (1.f + __expf(-c1)); c2 = c2 / (1.f + __expf(-c2));
            a0 += w * c0; a1 += w * c1; a2 += w * c2;
        }
        LAS float* red = (LAS float*)lds;
        __syncthreads();
#pragma unroll
        for (int j = 0; j < 4; ++j) { red[(ks * 16 + cg) * 12 + j] = a0[j]; red[(ks * 16 + cg) * 12 + 4 + j] = a1[j]; red[(ks * 16 + cg) * 12 + 8 + j] = a2[j]; }
        __syncthreads();
        if (tid < 192) {
            const int cgi = tid / 12, e = tid % 12;
            float s = 0.f;
#pragma unroll
            for (int k2 = 0; k2 < 16; ++k2) s += red[(k2 * 16 + cgi) * 12 + e];
            const int seg = e >> 2, c = cchunk * 64 + cgi * 4 + (e & 3);
            ((float*)(ws + WS_MOD))[((size_t)l * 3 + seg) * 6144 + c] = s + p.in[I_BMOD][(size_t)l * 6144 + c];
        }
        __syncthreads();
        return;
    }
    u -= N_MODU;
    if (u < N_CACHEU) {
        const int e4 = (u * 256 + tid) * 4;
        if (e4 >= N_CACHE_ELEMS) return;
        constexpr int PER_LB = 4 * 256 * 64 * 4 + 256 * 128 + 256 * 32;
        const int lb = e4 / PER_LB, r = e4 % PER_LB, l = lb >> 1, b = lb & 1;
        const float* src; bf16_t* dst;
        if (r < 4 * 65536) {
            const int which = r >> 16, off = r & 65535;
            const int ii = which == 0 ? I_CDAK : which == 1 ? I_CDAV : which == 2 ? I_CNAK : I_CNAV;
            const size_t wo = which == 0 ? WS_KCDA : which == 1 ? WS_VCDA : which == 2 ? WS_KCNA : WS_VCNA;
            src = p.in[ii] + ((size_t)(b * 2 + l)) * 65536 + off;
            dst = (bf16_t*)(ws + wo) + ((size_t)(l * 2 + b)) * 65536 + off;
        } else if (r < 4 * 65536 + 32768) {
            const int off = r - 4 * 65536;
            src = p.in[I_CCKV] + ((size_t)(b * 2 + l)) * 32768 + off;
            dst = (bf16_t*)(ws + WS_CKVA) + ((size_t)l * 8704 + 8192 + b * 256) * 128 + off;
        } else {
            const int off = r - 4 * 65536 - 32768;
            src = p.in[I_CKR] + ((size_t)(b * 2 + l)) * 8192 + off;
            dst = (bf16_t*)(ws + WS_KRC) + ((size_t)(l * 2 + b)) * 8192 + off;
        }
        const f32x4 v = *(const f32x4*)src;
        store_bf16x4(dst, v);
        return;
    }
    u -= N_CACHEU;
    for (int e = tid; e < 512; e += 256) {
        const int pos = e >> 3, i = e & 7;
        const float freq = powf(10000.0f, -(float)i / 8.0f);
        const float ang = (float)pos * freq;
        ((float*)(ws + WS_ROPE))[e] = cosf(ang);
        ((float*)(ws + WS_ROPE))[512 + e] = sinf(ang);
    }
}
constexpr int N_PRO_UNITS = N_TR + N_MODU + N_CACHEU + 1;

DI void norm_rows(const Params& p, int l, int which, int unit, bool from_input) {
    const int tid = opaque_tid(), wid = tid >> 6, lane = tid & 63;
    const int row = unit * 4 + wid;
    const float* x = from_input ? x_in_row(p, row) : (const float*)(p.ws + WS_XRES) + (size_t)row * 1024;
    const int seg = seg_of_row(row);
    const float* mod = (const float*)(p.ws + WS_MOD) + ((size_t)l * 3 + seg) * 6144;
    const float* sh = mod + (which ? 3 : 0) * 1024, *sc = mod + (which ? 4 : 1) * 1024;
    const float* g = p.in[which ? I_GFF : I_GMIX] + l * 1024;
    f32x4 v[4]; float s = 0.f;
#pragma unroll
    for (int i = 0; i < 4; ++i) { v[i] = *(const f32x4*)(x + i * 256 + lane * 4); s += v[i][0] * v[i][0] + v[i][1] * v[i][1] + v[i][2] * v[i][2] + v[i][3] * v[i][3]; }
    s = wave_sum(s);
    const float rstd = rsqrtf(s * (1.0f / 1024.0f) + EPS);
    bf16_t* h = (bf16_t*)(p.ws + WS_H) + (size_t)row * 1024;
#pragma unroll
    for (int i = 0; i < 4; ++i) {
        const int c = i * 256 + lane * 4;
        const f32x4 gg = *(const f32x4*)(g + c), s1 = *(const f32x4*)(sc + c), s0 = *(const f32x4*)(sh + c);
        f32x4 o = v[i] * rstd * gg * (s1 + 1.0f) + s0;
        store_bf16x4(h + c, o);
    }
}
DI void final_norm_rows(const Params& p, int unit) {
    const int tid = opaque_tid(), wid = tid >> 6, lane = tid & 63;
    const int row = unit * 4 + wid;
    const float* x = (const float*)(p.ws + WS_XRES) + (size_t)row * 1024;
    const float* g = p.in[I_GFIN];
    f32x4 v[4]; float s = 0.f;
#pragma unroll
    for (int i = 0; i < 4; ++i) { v[i] = *(const f32x4*)(x + i * 256 + lane * 4); s += v[i][0] * v[i][0] + v[i][1] * v[i][1] + v[i][2] * v[i][2] + v[i][3] * v[i][3]; }
    s = wave_sum(s);
    const float rstd = rsqrtf(s * (1.0f / 1024.0f) + EPS);
    float* y = p.out + (size_t)row * 1024;
#pragma unroll
    for (int i = 0; i < 4; ++i) { const int c = i * 256 + lane * 4; *(f32x4*)(y + c) = v[i] * rstd * *(const f32x4*)(g + c); }
}


typedef short s16x4 __attribute__((ext_vector_type(4)));
DI s16x4 lds_tr16(LAS const unsigned char* p) { return __builtin_bit_cast(s16x4, __builtin_amdgcn_ds_read_tr16_b64_v4i16((LAS s16x4*)p)); }
constexpr int AT_K = 0, AT_R = 8192, AT_V = 12288, AT_BUF = 20480, AT_RPB = 40960;
constexpr float LOG2E = 1.4426950408889634f;

struct TileSrc { const unsigned char* k; const unsigned char* v; const unsigned char* r; int pk, pv, pr; };

template <int MODE>
DI TileSrc attn_tile_src(const Params& p, int l, int b, int hh, bool lat, int own0, int na_rs, int t) {
    unsigned char* ws = p.ws; TileSrc s; s.r = nullptr; s.pr = 0;
    const int nct = lat ? 4 : 0;
    if (t < nct) {
        if (MODE == 1) {
            const size_t krow = 8192 + b * 256 + t * 64;
            s.k = ws + WS_KVM + (krow * 512 + hh * 128) * 2; s.v = s.k + 128; s.pk = s.pv = 1024;
            s.r = ws + WS_KRC + ((size_t)(l * 2 + b) * 256 + t * 64) * 64; s.pr = 64;
        } else {
            const size_t off = ((((size_t)(l * 2 + b) * 4 + hh) * 256) + t * 64) * 128;
            s.k = ws + (MODE == 0 ? WS_KCDA : WS_KCNA) + off; s.v = ws + (MODE == 0 ? WS_VCDA : WS_VCNA) + off; s.pk = s.pv = 128;
        }
    } else {
        const int a = t - nct;
        const size_t row = own0 + (size_t)((MODE == 2 && lat) ? (na_rs + a) : a) * 64;
        if (MODE == 1) {
            s.k = ws + WS_KVM + (row * 512 + hh * 128) * 2; s.v = s.k + 128; s.pk = s.pv = 1024;
            s.r = ws + WS_KRA + row * 64; s.pr = 64;
        } else {
            s.k = ws + (MODE == 0 ? WS_KDA : WS_KNA) + (row * 256 + hh * 64) * 2; s.v = ws + (MODE == 0 ? WS_VDA : WS_VNA) + (row * 256 + hh * 64) * 2; s.pk = s.pv = 512;
        }
    }
    return s;
}

template <int MODE>
DI void attn_unit(const Params& p, int l, int b, int hh, bool lat, int q0tok, int own0, int ntiles, int na_r, LAS unsigned char* lds) {
    const int tid = opaque_tid(), wv = tid >> 6, lane = tid & 63, g = lane >> 4, c = lane & 15;
    unsigned char* ws = p.ws;
    constexpr int NMAP = (MODE == 0) ? 2 : 1;
    constexpr int NKS = (MODE == 0) ? 1 : (MODE == 1 ? 3 : 2);
    const float scale = (MODE == 0) ? 0.17677669529663687f : (MODE == 1 ? 0.10206207261596577f : 0.125f);
    const float c1 = scale * LOG2E;
    const int na_rs = (MODE == 2 && lat) ? min(max(na_r - 4, 0), 24) : 0;
    const bool na_loc = (MODE == 2 && lat);
    const int qtok = q0tok + wv * 16 + c;
    bf16x8 qf[NMAP][NKS];
    if (MODE == 0) {
        const bf16_t* q = (const bf16_t*)(ws + WS_QDA) + (size_t)qtok * 256 + hh * 64;
        qf[0][0] = *(const bf16x8*)(q + 8 * g); qf[NMAP - 1][0] = *(const bf16x8*)(q + 32 + 8 * g);
    } else if (MODE == 1) {
        const bf16_t* q = (const bf16_t*)(ws + WS_QM) + (size_t)qtok * 384;
        qf[0][0] = *(const bf16x8*)(q + hh * 64 + 8 * g); qf[0][1 % NKS] = *(const bf16x8*)(q + hh * 64 + 32 + 8 * g); qf[0][2 % NKS] = *(const bf16x8*)(q + 256 + hh * 32 + 8 * g);
    } else {
        const bf16_t* q = (const bf16_t*)(ws + WS_QNA) + (size_t)qtok * 256 + hh * 64;
        qf[0][0] = *(const bf16x8*)(q + 8 * g); qf[0][1 % NKS] = *(const bf16x8*)(q + 32 + 8 * g);
    }
    const int rowA = tid >> 3, chA = tid & 7, rowB = rowA + 32;
    const int kdstA = rowA * 128 + ((chA ^ ((rowA >> 1) & 7)) << 4), kdstB = rowB * 128 + ((chA ^ ((rowB >> 1) & 7)) << 4);
    const int vdstA = rowA * 128 + ((chA ^ (((rowA >> 1) & 3) << 1)) << 4), vdstB = rowB * 128 + ((chA ^ (((rowB >> 1) & 3) << 1)) << 4);
    const int rrow = tid >> 2, rch = tid & 3, rdst = rrow * 64 + ((rch ^ ((-(rrow >> 2)) & 3)) << 4);
    u32x4 rk0, rk1, rv0, rv1, rr0;
    rr0 = (u32x4){0u, 0u, 0u, 0u};
#define AT_LOAD(t_) do { const TileSrc s_ = attn_tile_src<MODE>(p, l, b, hh, lat, own0, na_rs, (t_)); \
        rk0 = *(const u32x4*)(s_.k + (size_t)rowA * s_.pk + chA * 16); rk1 = *(const u32x4*)(s_.k + (size_t)rowB * s_.pk + chA * 16); \
        rv0 = *(const u32x4*)(s_.v + (size_t)rowA * s_.pv + chA * 16); rv1 = *(const u32x4*)(s_.v + (size_t)rowB * s_.pv + chA * 16); \
        if (MODE == 1) rr0 = *(const u32x4*)(s_.r + (size_t)rrow * s_.pr + rch * 16); } while (0)
#define AT_WRITE(buf_) do { LAS unsigned char* d_ = lds + (buf_) * AT_BUF; \
        *(LAS u32x4*)(d_ + AT_K + kdstA) = rk0; *(LAS u32x4*)(d_ + AT_K + kdstB) = rk1; \
        *(LAS u32x4*)(d_ + AT_V + vdstA) = rv0; *(LAS u32x4*)(d_ + AT_V + vdstB) = rv1; \
        if (MODE == 1) *(LAS u32x4*)(d_ + AT_R + rdst) = rr0; } while (0)
    __syncthreads();
    if (na_loc) {
        const float* rpb = p.in[I_RPB] + ((size_t)l * 4 + hh) * 465;
        for (int e = tid; e < 465; e += 256) ((LAS float*)(lds + AT_RPB))[e] = rpb[e] * LOG2E;
    }
    AT_LOAD(0); AT_WRITE(0);
    if (ntiles > 1) AT_LOAD(1);
    __syncthreads();
    const int ksw = (c >> 1) & 7;
    const int koff0 = c * 128 + ((g ^ ksw) << 4), koff1 = c * 128 + (((4 + g) ^ ksw) << 4);
    const int roff = c * 64 + ((g ^ ((-(c >> 2)) & 3)) << 4);
    const int vq = c >> 2, vpp = c & 3;
    const int vrow0 = 4 * g + vq;
    const int vsw = ((vrow0 >> 1) & 3) << 1;
    float m_run[NMAP], l_run[NMAP];
    f32x4 o[NMAP][4];
#pragma unroll
    for (int mp = 0; mp < NMAP; ++mp) { m_run[mp] = -1e30f; l_run[mp] = 0.f;
#pragma unroll
        for (int n = 0; n < 4; ++n) o[mp][n] = (f32x4){0.f, 0.f, 0.f, 0.f}; }
    const int wq = wv * 16 + c;
    const int na_cs = min(max(wq - 8, 0), 48);
    for (int t = 0; t < ntiles; ++t) {
        if (t + 1 < ntiles) AT_WRITE((t + 1) & 1);
        if (t + 2 < ntiles) AT_LOAD(t + 2);
        LAS const unsigned char* kb = lds + (t & 1) * AT_BUF + AT_K;
        LAS const unsigned char* rb = lds + (t & 1) * AT_BUF + AT_R;
        LAS const unsigned char* vb = lds + (t & 1) * AT_BUF + AT_V;
        bf16x8 pf[NMAP][2];
#pragma unroll
        for (int mp = 0; mp < NMAP; ++mp) {
            f32x4 s[4];
#pragma unroll
            for (int blk = 0; blk < 4; ++blk) {
                f32x4 a = (f32x4){0.f, 0.f, 0.f, 0.f};
                if (MODE == 0) {
                    const bf16x8 kf = *(LAS const bf16x8*)(kb + blk * 2048 + (mp == 0 ? koff0 : koff1));
                    a = __builtin_amdgcn_mfma_f32_16x16x32_bf16(kf, qf[mp][0], a, 0, 0, 0);
                } else {
                    const bf16x8 kf0 = *(LAS const bf16x8*)(kb + blk * 2048 + koff0), kf1 = *(LAS const bf16x8*)(kb + blk * 2048 + koff1);
                    a = __builtin_amdgcn_mfma_f32_16x16x32_bf16(kf0, qf[0][0], a, 0, 0, 0);
                    a = __builtin_amdgcn_mfma_f32_16x16x32_bf16(kf1, qf[0][1 % NKS], a, 0, 0, 0);
                    if (MODE == 1) { const bf16x8 kf2 = *(LAS const bf16x8*)(rb + blk * 1024 + roff); a = __builtin_amdgcn_mfma_f32_16x16x32_bf16(kf2, qf[0][2 % NKS], a, 0, 0, 0); }
                }
                s[blk] = a;
            }
            const bool loc_tile = na_loc && t >= 4;
            if (loc_tile) {
                const int dr = na_rs + (t - 4) - na_r + 7;
                LAS const float* brow = (LAS const float*)(lds + AT_RPB) + dr * 31;
#pragma unroll
                for (int blk = 0; blk < 4; ++blk)
#pragma unroll
                    for (int i = 0; i < 4; ++i) {
                        const int wk = 16 * blk + 4 * g + i;
                        const bool ok = (wk >= na_cs) && (wk < na_cs + 16);
                        const int idx = min(max(wk - wq + 15, 0), 30);
                        s[blk][i] = ok ? (s[blk][i] * c1 + brow[idx]) : -INFINITY;
                    }
            } else {
#pragma unroll
                for (int blk = 0; blk < 4; ++blk) s[blk] = s[blk] * c1;
            }
            float mx = fmaxf(fmaxf(fmaxf(s[0][0], s[0][1]), fmaxf(s[0][2], s[0][3])), fmaxf(fmaxf(s[1][0], s[1][1]), fmaxf(s[1][2], s[1][3])));
            mx = fmaxf(mx, fmaxf(fmaxf(fmaxf(s[2][0], s[2][1]), fmaxf(s[2][2], s[2][3])), fmaxf(fmaxf(s[3][0], s[3][1]), fmaxf(s[3][2], s[3][3]))));
            mx = fmaxf(mx, __shfl_xor(mx, 16)); mx = fmaxf(mx, __shfl_xor(mx, 32));
            const float mn = fmaxf(m_run[mp], mx), alpha = __builtin_amdgcn_exp2f(m_run[mp] - mn);
            m_run[mp] = mn;
            float ps = 0.f;
#pragma unroll
            for (int blk = 0; blk < 4; ++blk)
#pragma unroll
                for (int i = 0; i < 4; ++i) { const float e = __builtin_amdgcn_exp2f(s[blk][i] - mn); s[blk][i] = e; ps += e; }
            l_run[mp] = l_run[mp] * alpha + ps;
#pragma unroll
            for (int n = 0; n < 4; ++n) o[mp][n] = o[mp][n] * alpha;
#pragma unroll
            for (int sidx = 0; sidx < 2; ++sidx) {
                u32x4 w;
                w.x = cvt_pk_bf16(s[2 * sidx][0], s[2 * sidx][1]); w.y = cvt_pk_bf16(s[2 * sidx][2], s[2 * sidx][3]);
                w.z = cvt_pk_bf16(s[2 * sidx + 1][0], s[2 * sidx + 1][1]); w.w = cvt_pk_bf16(s[2 * sidx + 1][2], s[2 * sidx + 1][3]);
                pf[mp][sidx] = __builtin_bit_cast(bf16x8, w);
            }
        }
#pragma unroll
        for (int sidx = 0; sidx < 2; ++sidx)
#pragma unroll
            for (int n = 0; n < 4; ++n) {
                const int chunk = (2 * n + (vpp >> 1)) ^ vsw;
                LAS const unsigned char* va = vb + (32 * sidx + vrow0) * 128 + (chunk << 4) + (vpp & 1) * 8;
                const s16x4 lo = lds_tr16(va), hi = lds_tr16(va + 16 * 128);
                bf16x8 vf; vf[0] = lo[0]; vf[1] = lo[1]; vf[2] = lo[2]; vf[3] = lo[3]; vf[4] = hi[0]; vf[5] = hi[1]; vf[6] = hi[2]; vf[7] = hi[3];
#pragma unroll
                for (int mp = 0; mp < NMAP; ++mp) o[mp][n] = __builtin_amdgcn_mfma_f32_16x16x32_bf16(vf, pf[mp][sidx], o[mp][n], 0, 0, 0);
            }
        __syncthreads();
    }
#undef AT_LOAD
#undef AT_WRITE
    float inv[NMAP];
#pragma unroll
    for (int mp = 0; mp < NMAP; ++mp) { float lt = l_run[mp]; lt += __shfl_xor(lt, 16); lt += __shfl_xor(lt, 32); inv[mp] = 1.0f / lt; }
    bf16_t* mix = (bf16_t*)(ws + WS_MIX) + (size_t)qtok * 1024 + MODE * 256 + hh * 64;
    if (MODE == 0) {
        float e1 = 0.f, e2 = 0.f;
        for (int i = 0; i < 32; ++i) { e1 += p.in[I_LQ1][l * 32 + i] * p.in[I_LK1][l * 32 + i]; e2 += p.in[I_LQ2][l * 32 + i] * p.in[I_LK2][l * 32 + i]; }
        const float lam_init = 0.8f - 0.6f * expf(-0.3f * (float)l);
        const float lam = expf(e1) - expf(e2) + lam_init;
        f32x4 r[4]; float ss = 0.f;
#pragma unroll
        for (int n = 0; n < 4; ++n) { r[n] = o[0][n] * inv[0] - o[NMAP - 1][n] * (lam * inv[NMAP - 1]); ss += r[n][0] * r[n][0] + r[n][1] * r[n][1] + r[n][2] * r[n][2] + r[n][3] * r[n][3]; }
        ss += __shfl_xor(ss, 16); ss += __shfl_xor(ss, 32);
        const float rs = rsqrtf(ss * (1.0f / 64.0f) + EPS) * (1.0f - lam_init);
#pragma unroll
        for (int n = 0; n < 4; ++n) { const f32x4 gs = *(const f32x4*)(p.in[I_GSUB] + l * 64 + 16 * n + 4 * g); store_bf16x4(mix + 16 * n + 4 * g, r[n] * rs * gs); }
    } else {
#pragma unroll
        for (int n = 0; n < 4; ++n) store_bf16x4(mix + 16 * n + 4 * g, o[0][n] * inv[0]);
    }
}

constexpr int N_MIX_UNITS = 1792;
DI void conv_unit(const Params& p, int l, int cu, LAS unsigned char* lds);
DI void mixer_unit(const Params& p, int l, int u, LAS unsigned char* lds) {
    if (u < 768) {
        const int mode = u >> 8, r = u & 255, b = r >> 7, hh = (r >> 5) & 3, qb = r & 31;
        const int own0 = 4096 + b * 2048, q0 = own0 + qb * 64;
        if (mode == 0) attn_unit<0>(p, l, b, hh, true, q0, own0, 36, -1, lds);
        else if (mode == 1) attn_unit<1>(p, l, b, hh, true, q0, own0, 36, -1, lds);
        else attn_unit<2>(p, l, b, hh, true, q0, own0, 12, qb, lds);
    } else if (u < 1536) {
        const int v = u - 768, mode = v >> 8, r = v & 255, b = r >> 4, hh = (r >> 2) & 3, qb = r & 3;
        const int own0 = b * 256, q0 = own0 + qb * 64;
        if (mode == 0) attn_unit<0>(p, l, b, hh, false, q0, own0, 4, -1, lds);
        else if (mode == 1) attn_unit<1>(p, l, b, hh, false, q0, own0, 4, -1, lds);
        else attn_unit<2>(p, l, b, hh, false, q0, own0, 4, -1, lds);
    } else conv_unit(p, l, u - 1536, lds);
}

DI void conv_unit(const Params& p, int l, int cu, LAS unsigned char* lds) {
    const int tid = opaque_tid(), c = tid, wid = tid >> 6, lane = tid & 63;
    unsigned char* ws = p.ws;
    const int t0 = cu * 32;
    const bool lat = t0 >= 4096;
    const int seq0 = lat ? 4096 + ((t0 - 4096) >> 11) * 2048 : (t0 >> 8) * 256, seqlen = lat ? 2048 : 256;
    const bf16_t* CU = (const bf16_t*)(ws + WS_CU);
    float w[31];
#pragma unroll
    for (int j = 0; j < 31; ++j) w[j] = p.in[I_CDW][((size_t)l * 31 + j) * 256 + c];
    const float bias = p.in[I_CB][l * 256 + c];
    LAS float* y = (LAS float*)lds;
    __syncthreads();
#pragma unroll 1
    for (int half = 0; half < 2; ++half) {
        float g[46];
#pragma unroll
        for (int i = 0; i < 46; ++i) {
            const int s = t0 - seq0 + half * 16 + i - 15;
            const int sc_ = min(max(s, 0), seqlen - 1);
            const size_t r = (size_t)(seq0 + sc_) * 512;
            const float a = bf2f(CU[r + c]), bb = bf2f(CU[r + 256 + c]);
            const float v = a / (1.f + __expf(-bb));
            g[i] = (s >= 0 && s < seqlen) ? v : 0.f;
        }
#pragma unroll
        for (int i = 0; i < 16; ++i) {
            float a = bias;
#pragma unroll
            for (int j = 0; j < 31; ++j) a += g[i + j] * w[j];
            y[(half * 16 + i) * 256 + c] = a;
        }
    }
    __syncthreads();
    const f32x4 lg = *(const f32x4*)(p.in[I_CLG] + l * 256 + lane * 4), lb = *(const f32x4*)(p.in[I_CLB] + l * 256 + lane * 4);
    for (int i = wid * 8; i < wid * 8 + 8; ++i) {
        f32x4 v = *(LAS const f32x4*)(y + i * 256 + lane * 4);
        const float mu = wave_sum(v[0] + v[1] + v[2] + v[3]) * (1.0f / 256.0f);
        const f32x4 d = v - mu;
        const float var = wave_sum(d[0] * d[0] + d[1] * d[1] + d[2] * d[2] + d[3] * d[3]) * (1.0f / 256.0f);
        const float rstd = rsqrtf(var + EPS);
        f32x4 o = d * rstd * lg + lb;
#pragma unroll
        for (int j = 0; j < 4; ++j) o[j] = o[j] / (1.f + __expf(-o[j]));
        store_bf16x4((bf16_t*)(ws + WS_MIX) + (size_t)(t0 + i) * 1024 + 768 + lane * 4, o);
    }
    __syncthreads();
}

#define XB_TMO      128
#define XB_XCNT(j)  (256  + 64 * (j))
#define XB_XSUB(j)  (1280 + 64 * (j))
#define XB_XGEN(j)  (2304 + 64 * (j))
#define XB_TOP      3328
#define XB_TOPGEN   3392
#define XCD_BAR_WORDS 3456
#define XB_SPIN_CAP (1u << 20)
DI unsigned xb_ld(unsigned* p) { return __hip_atomic_load(p, __ATOMIC_RELAXED, __HIP_MEMORY_SCOPE_AGENT); }
DI unsigned xb_add(unsigned* p, unsigned v) { return __hip_atomic_fetch_add(p, v, __ATOMIC_RELAXED, __HIP_MEMORY_SCOPE_AGENT); }
DI unsigned xb_xcc_id() { return (unsigned)__builtin_amdgcn_s_getreg((3 << 11) | 20) & 0xFu; }
#define XB_SPIN(cond, bar) do { unsigned _sp = 0; while (cond) { __builtin_amdgcn_s_sleep(1); \
    if ((++_sp & 255u) == 0u) { if (xb_ld(&(bar)[XB_TMO])) break; if (_sp > XB_SPIN_CAP) { atomicAdd(&(bar)[XB_TMO], 1u); break; } } } } while (0)
struct XcdBarrier { unsigned* bar; unsigned x; volatile LAS unsigned* st; };
DI XcdBarrier xcd_barrier_post(unsigned* bar, volatile LAS unsigned* st) {
    XcdBarrier b; b.bar = bar; b.x = xb_xcc_id(); b.st = st;
    if (threadIdx.x == 0) (void)xb_add(&bar[XB_XCNT(b.x)], 1u);
    return b;
}
DI void xcd_barrier_complete(unsigned* bar, unsigned x, unsigned& nloc, unsigned& nx) {
    const unsigned G = gridDim.x;
    unsigned sum, cnt, mine, sp = 0u;
    for (;;) {
        sum = 0u; cnt = 0u; mine = 0u;
#pragma unroll
        for (unsigned j = 0; j < 16; ++j) { const unsigned c = xb_ld(&bar[XB_XCNT(j)]); sum += c; cnt += (c > 0u) ? 1u : 0u; mine = (j == x) ? c : mine; }
        if (sum == G) break;
        __builtin_amdgcn_s_sleep(1);
        if ((++sp & 255u) == 0u) { if (xb_ld(&bar[XB_TMO])) break; if (sp > XB_SPIN_CAP) { atomicAdd(&bar[XB_TMO], 1u); break; } }
    }
    nloc = mine > 0u ? mine : 1u; nx = cnt > 0u ? cnt : 1u;
}
DI void xcd_barrier(const XcdBarrier& b) {
    asm volatile("s_waitcnt vmcnt(0)" ::: "memory");
    __syncthreads();
    if (threadIdx.x == 0) {
        unsigned* bar = b.bar;
        __builtin_amdgcn_s_waitcnt(0);
        unsigned nloc = b.st[0], nx = b.st[1];
        if (nloc == 0u) { xcd_barrier_complete(bar, b.x, nloc, nx); b.st[0] = nloc; b.st[1] = nx; }
        const unsigned old = xb_add(&bar[XB_XSUB(b.x)], 1u);
        const unsigned gen = old / nloc;
        if (old + 1u == (gen + 1u) * nloc) {
            __builtin_amdgcn_fence(__ATOMIC_RELEASE, "agent");
            asm volatile("s_waitcnt vmcnt(0)" ::: "memory");
            const unsigned og = xb_add(&bar[XB_TOP], 1u);
            const unsigned tg = og / nx;
            if (og + 1u == (tg + 1u) * nx) xb_add(&bar[XB_TOPGEN], 1u);
            else XB_SPIN(xb_ld(&bar[XB_TOPGEN]) == tg, bar);
            __builtin_amdgcn_fence(__ATOMIC_ACQUIRE, "agent");
            xb_add(&bar[XB_XGEN(b.x)], 1u);
            asm volatile("s_waitcnt vmcnt(0)" ::: "memory");
        } else {
            XB_SPIN(xb_ld(&bar[XB_XGEN(b.x)]) == gen, bar);
            __builtin_amdgcn_fence(__ATOMIC_ACQUIRE, "agent");
            asm volatile("s_waitcnt vmcnt(0)" ::: "memory");
        }
    }
    __syncthreads();
}

constexpr int N_PHASES = 18;
typedef const unsigned char __attribute__((address_space(4)))* kaptr_t;
#define FRESH_PARAMS(pp) kaptr_t ka_ = (kaptr_t)__builtin_amdgcn_kernarg_segment_ptr(); asm volatile("" : "+s"(ka_)); const Params& pp = *(const Params*)ka_

__global__ void __launch_bounds__(256, 2) mk_fwd(Params p_, int ph_lo, int ph_hi) {
    extern __shared__ __attribute__((aligned(16))) unsigned char smem[];
    LAS unsigned char* lds = (LAS unsigned char*)smem;
    const int G = gridDim.x, bid = blockIdx.x;
    volatile LAS unsigned* bst = (volatile LAS unsigned*)(lds + 65536);
    XcdBarrier xb;
    const bool multi = (ph_hi - ph_lo) > 1;
    if (multi) {
        if (threadIdx.x == 0) { bst[0] = 0u; bst[1] = 0u; }
        __syncthreads();
        xb = xcd_barrier_post((unsigned*)(p_.ws + WS_BAR), bst);
    }
    for (int ph = ph_lo; ph < ph_hi; ++ph) {
        if (ph == 0) {
            for (int u = bid; u < N_PRO_UNITS; u += G) { FRESH_PARAMS(p); prologue_unit(p, u, lds); }
        } else if (ph == 17) {
            for (int u = bid; u < NTOK / 4; u += G) { FRESH_PARAMS(p); final_norm_rows(p, u); }
        } else {
            const int l = (ph - 1) >> 3, sub = (ph - 1) & 7;
            if (sub == 0) { for (int u = bid; u < NTOK / 4; u += G) { FRESH_PARAMS(p); norm_rows(p, l, 0, u, l == 0); } }
            else if (sub == 5) { for (int u = bid; u < NTOK / 4; u += G) { FRESH_PARAMS(p); norm_rows(p, l, 1, u, false); } }
            else if (sub == 1) {
                for (int u = bid; u < 64 * 20; u += G) { FRESH_PARAMS(p); int tm, tn; tile_of_unit(u, 64 * 20, G, 20, 64, tm, tn); f32x4 acc[4][4];
                    gemm_tile((const bf16_t*)(p.ws + WS_H), (const bf16_t*)(p.ws + WS_WTIN) + (size_t)l * NIN * 1024, 1024, tm * 128, tn * 128, lds, acc); epi_inproj(p, l, acc, tm, tn, lds); }
            } else if (sub == 2) {
                for (int u = bid; u < 64 * 3 + 68 * 4; u += G) { FRESH_PARAMS(p);
                    f32x4 acc[4][4];
                    if (u < 192) { const int tm = u / 3, tn = u % 3; gemm_tile((const bf16_t*)(p.ws + WS_QD), (const bf16_t*)(p.ws + WS_WTQUP) + (size_t)l * 384 * 256, 256, tm * 128, tn * 128, lds, acc); epi_qup(p, acc, tm, tn); }
                    else { const int v = u - 192, tm = v / 4, tn = v % 4; gemm_tile((const bf16_t*)(p.ws + WS_CKVA) + (size_t)l * 8704 * 128, (const bf16_t*)(p.ws + WS_WTKV) + (size_t)l * 512 * 128, 128, tm * 128, tn * 128, lds, acc); epi_kvup(p, acc, tm, tn); }
                }
            } else if (sub == 3) {
                for (int u = bid; u < N_MIX_UNITS; u += G) { FRESH_PARAMS(p); mixer_unit(p, l, u, lds); }
            } else if (sub == 4) {
                for (int u = bid; u < 64 * 8; u += G) { FRESH_PARAMS(p); int tm, tn; tile_of_unit(u, 64 * 8, G, 8, 64, tm, tn); f32x4 acc[4][4];
                    gemm_tile((const bf16_t*)(p.ws + WS_MIX), (const bf16_t*)(p.ws + WS_WTOUT) + (size_t)l * 1024 * 1024, 1024, tm * 128, tn * 128, lds, acc); epi_resid(p, l, acc, tm, tn, 2, l == 0); }
            } else if (sub == 6) {
                for (int u = bid; u < 64 * 32; u += G) { FRESH_PARAMS(p); int tm, tn; tile_of_unit(u, 64 * 32, G, 32, 64, tm, tn); f32x4 acc[4][4];
                    gemm_tile((const bf16_t*)(p.ws + WS_H), (const bf16_t*)(p.ws + WS_WTFF1) + (size_t)l * 4096 * 1024, 1024, tm * 128, tn * 128, lds, acc); epi_ff1(p, acc, tm, tn); }
            } else {
                for (int u = bid; u < 64 * 8; u += G) { FRESH_PARAMS(p); int tm, tn; tile_of_unit(u, 64 * 8, G, 8, 64, tm, tn); f32x4 acc[4][4];
                    gemm_tile((const bf16_t*)(p.ws + WS_HBUF), (const bf16_t*)(p.ws + WS_WTFF2) + (size_t)l * 1024 * 4096, 4096, tm * 128, tn * 128, lds, acc); epi_resid(p, l, acc, tm, tn, 5, false); }
            }
        }
        if (multi && ph + 1 < ph_hi) xcd_barrier(xb);
    }
}

#ifndef MK_ONE_LAUNCH
#define MK_ONE_LAUNCH 1
#endif
extern "C" void kernel_launch(void* const* d_in, const int* in_sizes, int n_in, void* d_out, int out_size, void* d_ws, size_t ws_size, hipStream_t stream) {
    static int grid = 0;
    if (grid == 0) {
        if (n_in != N_IN || ws_size < WS_END) { fprintf(stderr, "kernel_launch: unexpected n_in %d / ws_size %zu (need %zu)\n", n_in, ws_size, (size_t)WS_END); grid = -1; return; }
        if (hipFuncSetAttribute((const void*)mk_fwd, hipFuncAttributeMaxDynamicSharedMemorySize, LDS_BYTES) != hipSuccess) { fprintf(stderr, "kernel_launch: hipFuncSetAttribute failed\n"); grid = -1; return; }
        int dev = 0, cus = 0, per_cu = 0;
        (void)hipGetDevice(&dev); (void)hipDeviceGetAttribute(&cus, hipDeviceAttributeMultiprocessorCount, dev);
        if (hipOccupancyMaxActiveBlocksPerMultiprocessor(&per_cu, (const void*)mk_fwd, 256, LDS_BYTES) != hipSuccess || per_cu < 1) per_cu = 1;
        if (per_cu > 2) per_cu = 2;
        grid = cus * per_cu;
        fprintf(stderr, "kernel_launch: %d CUs x %d blocks\n", cus, per_cu);
    }
    if (grid < 0) return;
    Params p{};
    for (int i = 0; i < N_IN; ++i) p.in[i] = (const float*)d_in[i];
    p.out = (float*)d_out; p.ws = (unsigned char*)d_ws;
#if MK_ONE_LAUNCH
    (void)hipMemsetAsync((unsigned char*)d_ws + WS_BAR, 0, XCD_BAR_WORDS * 4, stream);
    int lo = 0, hi = N_PHASES;
    void* args[] = {&p, &lo, &hi};
    hipError_t e = hipLaunchCooperativeKernel((const void*)mk_fwd, dim3(grid), dim3(256), args, LDS_BYTES, stream);
    if (e != hipSuccess) fprintf(stderr, "cooperative launch failed: %s (grid %d)\n", hipGetErrorString(e), grid);
#else
    for (int ph = 0; ph < N_PHASES; ++ph) hipLaunchKernelGGL(mk_fwd, dim3(grid), dim3(256), LDS_BYTES, stream, p, ph, ph + 1);
#endif
}
```

```cpp
#include <hip/hip_runtime.h>
#include <cstdint>
#include <cstdio>

typedef unsigned short bf16_t;
typedef short bf16x8 __attribute__((ext_vector_type(8)));
typedef short s16x4 __attribute__((ext_vector_type(4)));
typedef float f32x4 __attribute__((ext_vector_type(4)));
typedef float f32x2 __attribute__((ext_vector_type(2)));
typedef unsigned u32x2 __attribute__((ext_vector_type(2)));
typedef unsigned u32x4 __attribute__((ext_vector_type(4)));
typedef __bf16 bf16x2v __attribute__((ext_vector_type(2)));
#define LAS __attribute__((address_space(3)))
#define DI __device__ __forceinline__

constexpr int NTOK = 8192, NLAYER = 2;
constexpr int NIN = 2560;
constexpr float EPS = 1e-6f;
constexpr float LOG2E = 1.4426950408889634f;
constexpr int NT = 512;
enum { I_XP = 0, I_XS, I_C, I_CDAK, I_CDAV, I_CCKV, I_CKR, I_CNAK, I_CNAV, I_CCTX, I_WMOD, I_BMOD, I_GMIX, I_GFF, I_WIN,
       I_LQ1, I_LK1, I_LQ2, I_LK2, I_GSUB, I_GMQ, I_WQUP, I_GMKV, I_WKVUP, I_RPB, I_CDW, I_CB, I_CLG, I_CLB, I_WOUT, I_WFF1, I_WFF2, I_GFIN, N_IN };
constexpr size_t O_DAK = 8388608, O_DAV = 10485760, O_CKV = 12582912, O_KR = 13631488, O_NAK = 13893632, O_NAV = 15990784;

constexpr size_t WS_BAR   = 0;
constexpr size_t WS_WTIN  = 32768;
constexpr size_t WS_WTQUP = WS_WTIN  + (size_t)NLAYER * NIN * 1024 * 2;
constexpr size_t WS_WTKV  = WS_WTQUP + (size_t)NLAYER * 384 * 256 * 2;
constexpr size_t WS_WTOUT = WS_WTKV  + (size_t)NLAYER * 512 * 128 * 2;
constexpr size_t WS_WTFF1 = WS_WTOUT + (size_t)NLAYER * 1024 * 1024 * 2;
constexpr size_t WS_WTFF2 = WS_WTFF1 + (size_t)NLAYER * 4096 * 1024 * 2;
constexpr size_t WS_MOD   = WS_WTFF2 + (size_t)NLAYER * 1024 * 4096 * 2;
constexpr size_t WS_ROPE  = WS_MOD   + (size_t)NLAYER * 3 * 6144 * 4;
constexpr size_t WS_H     = WS_ROPE  + 4096;
constexpr size_t WS_QDA   = WS_H     + (size_t)NTOK * 1024 * 2;
constexpr size_t WS_KDA   = WS_QDA   + (size_t)NTOK * 256 * 2;
constexpr size_t WS_VDA   = WS_KDA   + (size_t)NTOK * 256 * 2;
constexpr size_t WS_QNA   = WS_VDA   + (size_t)NTOK * 256 * 2;
constexpr size_t WS_KNA   = WS_QNA   + (size_t)NTOK * 256 * 2;
constexpr size_t WS_VNA   = WS_KNA   + (size_t)NTOK * 256 * 2;
constexpr size_t WS_QD    = WS_VNA   + (size_t)NTOK * 256 * 2;
constexpr size_t WS_SSQQ  = WS_QD    + (size_t)NTOK * 256 * 2;
constexpr size_t WS_CKVA  = WS_SSQQ  + (size_t)NTOK * 4 * 4;
constexpr size_t WS_KRA   = WS_CKVA  + (size_t)NLAYER * 8704 * 128 * 2;
constexpr size_t WS_KRC   = WS_KRA   + (size_t)NTOK * 32 * 2;
constexpr size_t WS_QM    = WS_KRC   + (size_t)NLAYER * 2 * 256 * 32 * 2;
constexpr size_t WS_KVM   = WS_QM    + (size_t)NTOK * 384 * 2;
constexpr size_t WS_KCDA  = WS_KVM   + (size_t)8704 * 512 * 2;
constexpr size_t WS_VCDA  = WS_KCDA  + (size_t)NLAYER * 2 * 4 * 256 * 64 * 2;
constexpr size_t WS_KCNA  = WS_VCDA  + (size_t)NLAYER * 2 * 4 * 256 * 64 * 2;
constexpr size_t WS_VCNA  = WS_KCNA  + (size_t)NLAYER * 2 * 4 * 256 * 64 * 2;
constexpr size_t WS_CU    = WS_VCNA  + (size_t)NLAYER * 2 * 4 * 256 * 64 * 2;
constexpr size_t WS_MIX   = WS_CU    + (size_t)NTOK * 512 * 2;
constexpr size_t WS_XRES  = WS_MIX   + (size_t)NTOK * 1024 * 2;
constexpr size_t WS_HBUF  = WS_XRES  + (size_t)NTOK * 1024 * 4;
constexpr size_t WS_SSQ1  = WS_HBUF  + (size_t)NTOK * 4096 * 2;
constexpr size_t WS_SSQ2  = WS_SSQ1  + (size_t)NTOK * 16 * 4;
constexpr size_t WS_BIAS1 = WS_SSQ2  + (size_t)NTOK * 16 * 4;
constexpr size_t WS_BIAS2 = WS_BIAS1 + (size_t)NLAYER * 3 * NIN * 4;
constexpr size_t WS_END   = WS_BIAS2 + (size_t)NLAYER * 3 * 4096 * 4;

struct Params { const float* in[N_IN]; float* out; unsigned char* ws; };

constexpr int GS_BYTES = 49152;
constexpr int LDS_MAIN = 3 * GS_BYTES;
constexpr int LDS_BYTES = LDS_MAIN + 64;

DI unsigned cvt_pk_bf16(float lo, float hi) { f32x2 v = {lo, hi}; return __builtin_bit_cast(unsigned, __builtin_convertvector(v, bf16x2v)); }
DI float bf2f(bf16_t v) { return __uint_as_float(((unsigned)v) << 16); }
DI float xmax16(float x) { const unsigned u = __builtin_bit_cast(unsigned, x); const auto r = __builtin_amdgcn_permlane16_swap(u, u, false, false);
    return fmaxf(__builtin_bit_cast(float, (unsigned)r[0]), __builtin_bit_cast(float, (unsigned)r[1])); }
DI float xmax32(float x) { const unsigned u = __builtin_bit_cast(unsigned, x); const auto r = __builtin_amdgcn_permlane32_swap(u, u, false, false);
    return fmaxf(__builtin_bit_cast(float, (unsigned)r[0]), __builtin_bit_cast(float, (unsigned)r[1])); }
DI int opaque_tid() { int t = threadIdx.x; asm volatile("" : "+v"(t)); return t; }
DI int opaque_bid() { int b = blockIdx.x; asm volatile("" : "+s"(b)); return b; }
DI float wave_sum(float v) {
#pragma unroll
    for (int o = 32; o > 0; o >>= 1) v += __shfl_xor(v, o);
    return v;
}
DI int seg_of_row(int row) { return row < 4096 ? 0 : (row < 6144 ? 1 : 2); }
DI const float* x_in_row(const Params& p, int row) { return row < 4096 ? p.in[I_XP] + (size_t)row * 1024 : p.in[I_XS] + (size_t)(row - 4096) * 1024; }
DI void store_bf16x4(bf16_t* dst, f32x4 v) { u32x2 w; w.x = cvt_pk_bf16(v[0], v[1]); w.y = cvt_pk_bf16(v[2], v[3]); *(u32x2*)dst = w; }
DI float rstd_from16(const float* sp, float inv_n) {
    const f32x4 s0 = *(const f32x4*)sp, s1 = *(const f32x4*)(sp + 4), s2 = *(const f32x4*)(sp + 8), s3 = *(const f32x4*)(sp + 12);
    const f32x4 st = (s0 + s1) + (s2 + s3);
    return rsqrtf((st[0] + st[1] + st[2] + st[3]) * inv_n + EPS);
}

DI void gemm_stage(const bf16_t* __restrict__ A, const bf16_t* __restrict__ Bt, int K, int row0, int col0, int k0, LAS unsigned char* st, int tid) {
#pragma unroll
    for (int i = 0; i < 4; ++i) {
        const int b = i * 8192 + tid * 16, row = b >> 7, lch = ((b >> 4) & 7) ^ ((row >> 1) & 7);
        __builtin_amdgcn_global_load_lds((const unsigned*)(A + (size_t)(row0 + row) * K + k0 + lch * 8), (LAS unsigned*)(st + b), 16, 0, 16);
    }
#pragma unroll
    for (int i = 0; i < 2; ++i) {
        const int b = i * 8192 + tid * 16, row = b >> 7, lch = ((b >> 4) & 7) ^ ((row >> 1) & 7);
        __builtin_amdgcn_global_load_lds((const unsigned*)(Bt + (size_t)(col0 + row) * K + k0 + lch * 8), (LAS unsigned*)(st + 32768 + b), 16, 0, 16);
    }
}
#define GEMM_READ_K(AF, BF, st_, offk_) do { LAS const unsigned char* s__ = (st_); \
        _Pragma("unroll") for (int m = 0; m < 4; ++m) AF[m] = *(LAS const bf16x8*)(s__ + abase + m * 2048 + (offk_)); \
        _Pragma("unroll") for (int n = 0; n < 4; ++n) BF[n] = *(LAS const bf16x8*)(s__ + bbase + n * 2048 + (offk_)); } while (0)
#define GEMM_READ_A(AF, st_, offk_) do { LAS const unsigned char* s__ = (st_); _Pragma("unroll") for (int m = 0; m < 4; ++m) AF[m] = *(LAS const bf16x8*)(s__ + abase + m * 2048 + (offk_)); } while (0)
#define GEMM_READ_B(BF, st_, offk_) do { LAS const unsigned char* s__ = (st_); _Pragma("unroll") for (int n = 0; n < 4; ++n) BF[n] = *(LAS const bf16x8*)(s__ + bbase + n * 2048 + (offk_)); } while (0)
#define GEMM_MMA_K(AF, BF) do { __builtin_amdgcn_s_setprio(1); \
        _Pragma("unroll") for (int m = 0; m < 4; ++m) _Pragma("unroll") for (int n = 0; n < 4; ++n) \
            acc[m][n] = __builtin_amdgcn_mfma_f32_16x16x32_bf16(BF[n], AF[m], acc[m][n], 0, 0, 0); \
        __builtin_amdgcn_s_setprio(0); } while (0)
#define GEMM_DMA_A_P(i_) do { const int b_ = (i_) * 8192 + tid * 16, row_ = b_ >> 7, lch_ = ((b_ >> 4) & 7) ^ ((row_ >> 1) & 7); \
        __builtin_amdgcn_global_load_lds((const unsigned*)(A + (size_t)(row0 + row_) * K + 128 + lch_ * 8), (LAS unsigned*)(lds + 2 * GS_BYTES + b_), 16, 0, 16); } while (0)
DI void gemm_tile(const bf16_t* __restrict__ A, const bf16_t* __restrict__ Bt, int K, int row0, int col0, LAS unsigned char* lds, f32x4 (&acc)[4][4], bool pf_first = true) {
    const int tid = opaque_tid(), wid = tid >> 6, lane = tid & 63, wr = wid >> 1, wc = wid & 1, fr = lane & 15, fq = lane >> 4;
#pragma unroll
    for (int m = 0; m < 4; ++m)
#pragma unroll
        for (int n = 0; n < 4; ++n) acc[m][n] = (f32x4){0.f, 0.f, 0.f, 0.f};
    const int sw = (fr >> 1) & 7;
    const int offk0 = ((0 + fq) ^ sw) << 4, offk1 = ((4 + fq) ^ sw) << 4;
    const int abase = (wr * 64 + fr) * 128, bbase = 32768 + (wc * 64 + fr) * 128;
    const int nt = K >> 6;
    (void)pf_first;
    asm volatile("s_waitcnt vmcnt(0)" ::: "memory");
    __builtin_amdgcn_s_barrier(); asm volatile("" ::: "memory");
    if (nt > 2) { GEMM_DMA_A_P(0); GEMM_DMA_A_P(1); GEMM_DMA_A_P(2); }
    bf16x8 ax[4], bx[4], ay[4], by[4];
    GEMM_READ_K(ax, bx, lds, offk0);
    int slot0 = 0, slot1 = GS_BYTES, slot2 = 2 * GS_BYTES;
#define GEMM_DMA_A(i_, kt_, slot_) do { const int b_ = (i_) * 8192 + tid * 16, row_ = b_ >> 7, lch_ = ((b_ >> 4) & 7) ^ ((row_ >> 1) & 7); \
        __builtin_amdgcn_global_load_lds((const unsigned*)(A + (size_t)(row0 + row_) * K + ((kt_) << 6) + lch_ * 8), (LAS unsigned*)(lds + (slot_) + b_), 16, 0, 16); } while (0)
#define GEMM_DMA_B(i_, kt_, slot_) do { const int b_ = (i_) * 8192 + tid * 16, row_ = b_ >> 7, lch_ = ((b_ >> 4) & 7) ^ ((row_ >> 1) & 7); \
        __builtin_amdgcn_global_load_lds((const unsigned*)(Bt + (size_t)(col0 + row_) * K + ((kt_) << 6) + lch_ * 8), (LAS unsigned*)(lds + (slot_) + 32768 + b_), 16, 0, 16); } while (0)
#define GEMM_ROW(AF, BF, m_) do { _Pragma("unroll") for (int n = 0; n < 4; ++n) acc[m_][n] = __builtin_amdgcn_mfma_f32_16x16x32_bf16(BF[n], AF[m_], acc[m_][n], 0, 0, 0); } while (0)
#define SB() __builtin_amdgcn_sched_barrier(0)
    for (int t = 0; t < nt; ++t) {
        const bool dma2 = t + 2 < nt;
#define MM(AF, BF, m_, n_) acc[m_][n_] = __builtin_amdgcn_mfma_f32_16x16x32_bf16(BF[n_], AF[m_], acc[m_][n_], 0, 0, 0)
#define RDA(AF, st_, offk_, m_) AF[m_] = *(LAS const bf16x8*)((st_) + abase + (m_) * 2048 + (offk_))
#define RDB(BF, st_, offk_, n_) BF[n_] = *(LAS const bf16x8*)((st_) + bbase + (n_) * 2048 + (offk_))
        { LAS const unsigned char* s0_ = lds + slot0;
        __builtin_amdgcn_s_setprio(1);
        MM(ax, bx, 0, 0); SB(); RDB(by, s0_, offk1, 0); SB(); MM(ax, bx, 0, 1); SB(); RDB(by, s0_, offk1, 1); SB();
        MM(ax, bx, 0, 2); SB(); RDB(by, s0_, offk1, 2); SB(); MM(ax, bx, 0, 3); SB(); RDB(by, s0_, offk1, 3); SB();
        MM(ax, bx, 1, 0); SB(); RDA(ay, s0_, offk1, 0); SB(); MM(ax, bx, 1, 1); SB(); RDA(ay, s0_, offk1, 1); SB();
        MM(ax, bx, 1, 2); SB(); RDA(ay, s0_, offk1, 2); SB(); MM(ax, bx, 1, 3); SB(); RDA(ay, s0_, offk1, 3); SB();
        MM(ax, bx, 2, 0); SB(); if (dma2) GEMM_DMA_A(3, t + 2, slot2); SB(); MM(ax, bx, 2, 1); MM(ax, bx, 2, 2); SB(); if (dma2) GEMM_DMA_B(0, t + 2, slot2); SB();
        MM(ax, bx, 2, 3); MM(ax, bx, 3, 0); SB(); if (dma2) GEMM_DMA_B(1, t + 2, slot2); SB(); MM(ax, bx, 3, 1); MM(ax, bx, 3, 2); MM(ax, bx, 3, 3);
        __builtin_amdgcn_s_setprio(0); }
        SB();
        const bool more = t + 1 < nt, dma3 = t + 3 < nt;
        if (more) {
            if (t + 2 < nt) asm volatile("s_waitcnt vmcnt(6) lgkmcnt(0)" ::: "memory"); else asm volatile("s_waitcnt vmcnt(0) lgkmcnt(0)" ::: "memory");
            __builtin_amdgcn_s_barrier(); asm volatile("" ::: "memory");
        }
        SB();
        { LAS const unsigned char* s1_ = lds + slot1;
        __builtin_amdgcn_s_setprio(1);
        MM(ay, by, 0, 0); SB(); if (more) RDB(bx, s1_, offk0, 0); SB(); MM(ay, by, 0, 1); SB(); if (more) RDB(bx, s1_, offk0, 1); SB();
        MM(ay, by, 0, 2); SB(); if (more) RDB(bx, s1_, offk0, 2); SB(); MM(ay, by, 0, 3); SB(); if (more) RDB(bx, s1_, offk0, 3); SB();
        MM(ay, by, 1, 0); SB(); if (more) RDA(ax, s1_, offk0, 0); SB(); MM(ay, by, 1, 1); SB(); if (more) RDA(ax, s1_, offk0, 1); SB();
        MM(ay, by, 1, 2); SB(); if (more) RDA(ax, s1_, offk0, 2); SB(); MM(ay, by, 1, 3); SB(); if (more) RDA(ax, s1_, offk0, 3); SB();
        MM(ay, by, 2, 0); SB(); if (dma3) GEMM_DMA_A(0, t + 3, slot0); SB(); MM(ay, by, 2, 1); MM(ay, by, 2, 2); SB(); if (dma3) GEMM_DMA_A(1, t + 3, slot0); SB();
        MM(ay, by, 2, 3); MM(ay, by, 3, 0); SB(); if (dma3) GEMM_DMA_A(2, t + 3, slot0); SB(); MM(ay, by, 3, 1); MM(ay, by, 3, 2); MM(ay, by, 3, 3);
        __builtin_amdgcn_s_setprio(0); }
        SB();
        { const int s0_ = slot0; slot0 = slot1; slot1 = slot2; slot2 = s0_; }
    }
}
DI void gemm_prefetch(const bf16_t* __restrict__ A, const bf16_t* __restrict__ Bt, int K, int row0, int col0, LAS unsigned char* lds) {
    const int tid = opaque_tid();
    asm volatile("s_waitcnt lgkmcnt(0)" ::: "memory");
    __builtin_amdgcn_s_barrier(); asm volatile("" ::: "memory");
    gemm_stage(A, Bt, K, row0, col0, 0, lds, tid);
    gemm_stage(A, Bt, K, row0, col0, 64, lds + GS_BYTES, tid);
}

struct RopeCS { f32x4 cr, sr, cc, sc; };
DI RopeCS rope_load(const float* ropetab, int prow, int pcol, int fq) {
    RopeCS r; const int o = 4 * (fq & 1);
    r.cr = *(const f32x4*)(ropetab + prow * 8 + o); r.sr = *(const f32x4*)(ropetab + 512 + prow * 8 + o);
    r.cc = *(const f32x4*)(ropetab + pcol * 8 + o); r.sc = *(const f32x4*)(ropetab + 512 + pcol * 8 + o);
    return r;
}
DI f32x4 rope4(f32x4 v, const RopeCS& t, bool colpart, int fq) {
    const f32x4 cs = colpart ? t.cc : t.cr, sn = colpart ? t.sc : t.sr;
    f32x4 o;
#pragma unroll
    for (int j = 0; j < 4; ++j) {
        const float pr = __shfl_xor(v[j], 32);
        o[j] = (fq >= 2) ? (pr * sn[j] + v[j] * cs[j]) : (v[j] * cs[j] - pr * sn[j]);
    }
    return o;
}
DI float rowsum16_lanes(const float* sp, int fq) {
    const f32x4 s = *(const f32x4*)(sp + 4 * fq);
    float t = (s[0] + s[1]) + (s[2] + s[3]);
    t += __shfl_xor(t, 16); t += __shfl_xor(t, 32);
    return t;
}

DI int ecol(int n, int fq, bool perm) { return perm ? 32 * (n >> 1) + 8 * fq + 4 * (n & 1) : 16 * n + 4 * fq; }
struct FoldPrep { f32x4 bv[4]; float rstd[4]; };
DI void fold_prep(FoldPrep& r, const float* bias_seg  , const float* ssq  , int tm, int tn, bool perm = false) {
    const int tid = opaque_tid(), wid = tid >> 6, lane = tid & 63, wr = wid >> 1, wc = wid & 1, fr = lane & 15, fq = lane >> 4;
    f32x4 sp[4];
#pragma unroll
    for (int n = 0; n < 4; ++n) r.bv[n] = *(const f32x4*)(bias_seg + tn * 128 + wc * 64 + ecol(n, fq, perm));
#pragma unroll
    for (int m = 0; m < 4; ++m) sp[m] = *(const f32x4*)(ssq + (size_t)(tm * 256 + wr * 64 + m * 16 + fr) * 16 + 4 * fq);
#pragma unroll
    for (int m = 0; m < 4; ++m) { float t = (sp[m][0] + sp[m][1]) + (sp[m][2] + sp[m][3]); t += __shfl_xor(t, 16); t += __shfl_xor(t, 32); r.rstd[m] = rsqrtf(t * (1.0f / 1024.0f) + EPS); }
}

struct RopeP { f32x4 c0, s0, c1, s1; };
DI RopeP ropep_load(const float* ropetab, int prow, int pcol, int fq) {
    RopeP r; const int pos = (fq < 2) ? prow : pcol;
    r.c0 = *(const f32x4*)(ropetab + pos * 8); r.c1 = *(const f32x4*)(ropetab + pos * 8 + 4);
    r.s0 = *(const f32x4*)(ropetab + 512 + pos * 8); r.s1 = *(const f32x4*)(ropetab + 512 + pos * 8 + 4);
    return r;
}
DI f32x4 ropep4(f32x4 v, const RopeP& t, int n, int fq) {
    const f32x4 cs = (n & 1) ? t.c1 : t.c0, sn = (n & 1) ? t.s1 : t.s0;
    f32x4 o;
#pragma unroll
    for (int j = 0; j < 4; ++j) {
        const float pr = __shfl_xor(v[j], 16);
        o[j] = (fq & 1) ? (pr * sn[j] + v[j] * cs[j]) : (v[j] * cs[j] - pr * sn[j]);
    }
    return o;
}
DI void store_bf16x8(bf16_t* dst, f32x4 a, f32x4 b) { *(u32x4*)dst = (u32x4){cvt_pk_bf16(a[0], a[1]), cvt_pk_bf16(a[2], a[3]), cvt_pk_bf16(b[0], b[1]), cvt_pk_bf16(b[2], b[3])}; }
DI void epi_inproj(const Params& p, int l, f32x4 (&acc)[4][4], int tm, int tn, LAS unsigned char* lds, const FoldPrep& fp) {
    const int tid = opaque_tid(), wid = tid >> 6, lane = tid & 63, wr = wid >> 1, wc = wid & 1, fr = lane & 15, fq = lane >> 4;
    unsigned char* ws = p.ws;
    const bool lat = tm >= 16;
    const float* ropetab = (const float*)(ws + WS_ROPE);
    float* out = p.out;
    RopeP rt[4];
    {
        const bool need_rope = lat && (tn < 4 || tn == 19);
#pragma unroll
        for (int m = 0; m < 4; ++m) {
            const int sl_ = (tm * 256 + wr * 64 + m * 16 + fr - 4096) & 2047;
            if (need_rope) rt[m] = ropep_load(ropetab, sl_ >> 6, sl_ & 63, fq);
        }
        if (l > 0) {
#pragma unroll
            for (int m = 0; m < 4; ++m) {
                const float rstd = fp.rstd[m];
#pragma unroll
                for (int n = 0; n < 4; ++n) acc[m][n] = acc[m][n] * rstd + fp.bv[n];
            }
        }
    }
    if (tn == 8) {
        LAS float* ex = (LAS float*)(lds + 2 * GS_BYTES);
        __syncthreads();
#pragma unroll
        for (int m = 0; m < 4; ++m) {
            float s = 0.f;
#pragma unroll
            for (int n = 0; n < 4; ++n)
#pragma unroll
                for (int j = 0; j < 4; ++j) s += acc[m][n][j] * acc[m][n][j];
            s += __shfl_xor(s, 16); s += __shfl_xor(s, 32);
            if (fq == 0) ex[(wr * 64 + m * 16 + fr) * 2 + wc] = s;
        }
        __syncthreads();
        const float* gkv = p.in[I_GMKV] + l * 128;
        bf16_t* ckva = (bf16_t*)(ws + WS_CKVA) + (size_t)l * 8704 * 128;
        f32x4 gk[4];
#pragma unroll
        for (int n = 0; n < 4; ++n) gk[n] = *(const f32x4*)(gkv + wc * 64 + ecol(n, fq, true));
#pragma unroll
        for (int m = 0; m < 4; ++m) {
            const int rl = wr * 64 + m * 16 + fr, row = tm * 256 + rl;
            const float rstd = rsqrtf((ex[rl * 2] + ex[rl * 2 + 1]) * (1.0f / 128.0f) + EPS);
#pragma unroll
            for (int q = 0; q < 2; ++q) {
                const int col = wc * 64 + 32 * q + 8 * fq;
                const f32x4 v0 = acc[m][2 * q] * rstd * gk[2 * q], v1 = acc[m][2 * q + 1] * rstd * gk[2 * q + 1];
                store_bf16x8(ckva + (size_t)row * 128 + col, v0, v1);
                if (!lat) { const int b = row >> 8, s = row & 255; float* o = out + O_CKV + ((size_t)(b * 2 + l) * 256 + s) * 128 + col; *(f32x4*)o = v0; *(f32x4*)(o + 4) = v1; }
            }
        }
        __syncthreads();
        return;
    }
#pragma unroll
    for (int m = 0; m < 4; ++m) {
        const int row = tm * 256 + wr * 64 + m * 16 + fr;
        const int cb = row >> 8, cs = row & 255;
        if (tn == 6 || tn == 7) {
            float s = 0.f;
#pragma unroll
            for (int n = 0; n < 4; ++n)
#pragma unroll
                for (int j = 0; j < 4; ++j) s += acc[m][n][j] * acc[m][n][j];
            s += __shfl_xor(s, 16); s += __shfl_xor(s, 32);
            if (fq == 0) ((float*)(ws + WS_SSQQ))[row * 4 + (tn - 6) * 2 + wc] = s;
        }
#pragma unroll
        for (int q = 0; q < 2; ++q) {
            const int cw = wc * 64 + 32 * q + 8 * fq;
            f32x4 v0 = acc[m][2 * q], v1 = acc[m][2 * q + 1];
            if (tn < 2) {
                if (lat) { v0 = ropep4(v0, rt[m], 0, fq); v1 = ropep4(v1, rt[m], 1, fq); }
                store_bf16x8((bf16_t*)(ws + WS_QDA) + (size_t)row * 256 + tn * 128 + cw, v0, v1);
            } else if (tn < 4) {
                if (lat) { v0 = ropep4(v0, rt[m], 0, fq); v1 = ropep4(v1, rt[m], 1, fq); }
                const int c = (tn - 2) * 128 + cw;
                store_bf16x8((bf16_t*)(ws + WS_KDA) + (size_t)row * 256 + c, v0, v1);
                if (!lat) { float* o = out + O_DAK + (((size_t)(cb * 2 + l) * 4 + (c >> 6)) * 256 + cs) * 64 + (c & 63); *(f32x4*)o = v0; *(f32x4*)(o + 4) = v1; }
            } else if (tn < 6) {
                const int c = (tn - 4) * 128 + cw;
                store_bf16x8((bf16_t*)(ws + WS_VDA) + (size_t)row * 256 + c, v0, v1);
                if (!lat) { float* o = out + O_DAV + (((size_t)(cb * 2 + l) * 4 + (c >> 6)) * 256 + cs) * 64 + (c & 63); *(f32x4*)o = v0; *(f32x4*)(o + 4) = v1; }
            } else if (tn < 8) {
                store_bf16x8((bf16_t*)(ws + WS_QD) + (size_t)row * 256 + (tn - 6) * 128 + cw, v0, v1);
            } else if (tn < 11) {
                store_bf16x8((bf16_t*)(ws + WS_QNA) + (size_t)row * 256 + (tn - 9) * 128 + cw, v0, v1);
            } else if (tn < 13) {
                const int c = (tn - 11) * 128 + cw;
                store_bf16x8((bf16_t*)(ws + WS_KNA) + (size_t)row * 256 + c, v0, v1);
                if (!lat) { float* o = out + O_NAK + (((size_t)(cb * 2 + l) * 4 + (c >> 6)) * 256 + cs) * 64 + (c & 63); *(f32x4*)o = v0; *(f32x4*)(o + 4) = v1; }
            } else if (tn < 15) {
                const int c = (tn - 13) * 128 + cw;
                store_bf16x8((bf16_t*)(ws + WS_VNA) + (size_t)row * 256 + c, v0, v1);
                if (!lat) { float* o = out + O_NAV + (((size_t)(cb * 2 + l) * 4 + (c >> 6)) * 256 + cs) * 64 + (c & 63); *(f32x4*)o = v0; *(f32x4*)(o + 4) = v1; }
            } else if (tn < 19) {
                store_bf16x8((bf16_t*)(ws + WS_CU) + (size_t)row * 512 + (tn - 15) * 128 + cw, v0, v1);
            } else {
                if (lat) { v0 = ropep4(v0, rt[m], 0, fq); v1 = ropep4(v1, rt[m], 1, fq); }
                if (wc == 0 && q == 0) {
                    store_bf16x8((bf16_t*)(ws + WS_KRA) + (size_t)row * 32 + cw, v0, v1);
                    if (!lat) { float* o = out + O_KR + ((size_t)(cb * 2 + l) * 256 + cs) * 32 + cw; *(f32x4*)o = v0; *(f32x4*)(o + 4) = v1; }
                }
            }
        }
    }
}

DI void epi_qup(const Params& p, f32x4 (&acc)[4][4], int tm, int tn) {
    const int tid = opaque_tid(), wid = tid >> 6, lane = tid & 63, wr = wid >> 1, wc = wid & 1, fr = lane & 15, fq = lane >> 4;
    unsigned char* ws = p.ws;
    const bool lat = tm >= 16;
    const float* ropetab = (const float*)(ws + WS_ROPE);
    f32x4 sq[4]; RopeCS rt[4];
#pragma unroll
    for (int m = 0; m < 4; ++m) {
        const int row = tm * 256 + wr * 64 + m * 16 + fr, sl = (row - 4096) & 2047;
        sq[m] = *(const f32x4*)((const float*)(ws + WS_SSQQ) + row * 4);
        if (tn == 2 && lat) rt[m] = rope_load(ropetab, sl >> 6, sl & 63, fq);
    }
#pragma unroll
    for (int m = 0; m < 4; ++m) {
        const int row = tm * 256 + wr * 64 + m * 16 + fr;
        const float rstd = rsqrtf((sq[m][0] + sq[m][1] + sq[m][2] + sq[m][3]) * (1.0f / 256.0f) + EPS);
#pragma unroll
        for (int n = 0; n < 4; ++n) {
            f32x4 v = acc[m][n] * rstd;
            if (tn == 2 && lat) v = rope4(v, rt[m], n & 1, fq);
            store_bf16x4((bf16_t*)(ws + WS_QM) + (size_t)row * 384 + tn * 128 + wc * 64 + n * 16 + 4 * fq, v);
        }
    }
}
DI void epi_kvup(const Params& p, f32x4 (&acc)[4][4], int tm, int tn) {
    const int tid = opaque_tid(), wid = tid >> 6, lane = tid & 63, wr = wid >> 1, wc = wid & 1, fr = lane & 15, fq = lane >> 4;
#pragma unroll
    for (int m = 0; m < 4; ++m) {
        const int row = tm * 256 + wr * 64 + m * 16 + fr;
#pragma unroll
        for (int n = 0; n < 4; ++n) store_bf16x4((bf16_t*)(p.ws + WS_KVM) + (size_t)row * 512 + tn * 128 + wc * 64 + n * 16 + 4 * fq, acc[m][n]);
    }
}
struct ResidPrep { u32x4 w[8]; };
DI void resid_prep(ResidPrep& r, const Params& p, int tm, int tn, bool from_input) {
    const int tid = opaque_tid(), wid = tid >> 6, lane = tid & 63, wr = wid >> 1, wc = wid & 1, fr = lane & 15, fq = lane >> 4;
    if (from_input) {
#pragma unroll
        for (int m = 0; m < 2; ++m) {
            const float* src = x_in_row(p, tm * 256 + wr * 64 + m * 16 + fr);
#pragma unroll
            for (int n = 0; n < 4; ++n) r.w[m * 4 + n] = __builtin_nontemporal_load((const u32x4*)(src + tn * 128 + wc * 64 + ecol(n, fq, true)));
        }
    } else {
        const bf16_t* xres = (const bf16_t*)(p.ws + WS_XRES);
#pragma unroll
        for (int m = 0; m < 4; ++m)
#pragma unroll
            for (int q = 0; q < 2; ++q) r.w[m * 2 + q] = __builtin_nontemporal_load((const u32x4*)(xres + (size_t)(tm * 256 + wr * 64 + m * 16 + fr) * 1024 + tn * 128 + wc * 64 + 32 * q + 8 * fq));
    }
}
DI void epi_resid(const Params& p, int l, f32x4 (&acc)[4][4], int tm, int tn, int gi, bool from_input, const float* gnext, int nl, int nsc, size_t ssq_off, const ResidPrep& r, bool keep = false) {
    const int tid = opaque_tid(), wid = tid >> 6, lane = tid & 63, wr = wid >> 1, wc = wid & 1, fr = lane & 15, fq = lane >> 4;
    bf16_t* xres = (bf16_t*)(p.ws + WS_XRES);
    const bool write_h = gnext != nullptr;
    const int seg = seg_of_row(tm * 256);
    const float* gate = (const float*)(p.ws + WS_MOD) + ((size_t)l * 3 + seg) * 6144 + gi * 1024;
    const float* scn = (const float*)(p.ws + WS_MOD) + ((size_t)nl * 3 + seg) * 6144 + nsc * 1024;
    f32x4 gt[4], gm[4];
#pragma unroll
    for (int n = 0; n < 4; ++n) {
        const int col = tn * 128 + wc * 64 + ecol(n, fq, true);
        gt[n] = *(const f32x4*)(gate + col);
        gm[n] = gnext ? *(const f32x4*)(gnext + col) * (*(const f32x4*)(scn + col) + 1.0f) : (f32x4){0.f, 0.f, 0.f, 0.f};
    }
    u32x4 xw[2][4];
    if (from_input) {
#pragma unroll
        for (int m = 2; m < 4; ++m) {
            const float* src = x_in_row(p, tm * 256 + wr * 64 + m * 16 + fr);
#pragma unroll
            for (int n = 0; n < 4; ++n) xw[m - 2][n] = __builtin_nontemporal_load((const u32x4*)(src + tn * 128 + wc * 64 + ecol(n, fq, true)));
        }
    }
#pragma unroll
    for (int m = 0; m < 4; ++m) {
        const int row = tm * 256 + wr * 64 + m * 16 + fr;
        float s = 0.f;
        unsigned hw[8], xb[8];
#pragma unroll
        for (int n = 0; n < 4; ++n) {
            f32x4 xo;
            if (from_input) xo = __builtin_bit_cast(f32x4, m < 2 ? r.w[(m & 1) * 4 + n] : xw[m & 1][n]);
            else { const u32x4 wv = r.w[m * 2 + (n >> 1)]; const unsigned lo = wv[2 * (n & 1)], hi = wv[2 * (n & 1) + 1];
                   xo = (f32x4){__builtin_bit_cast(float, lo << 16), __builtin_bit_cast(float, lo & 0xffff0000u), __builtin_bit_cast(float, hi << 16), __builtin_bit_cast(float, hi & 0xffff0000u)}; }
            const f32x4 xn = xo + gt[n] * acc[m][n];
            if (keep) acc[m][n] = xn;
            xb[2 * n] = cvt_pk_bf16(xn[0], xn[1]); xb[2 * n + 1] = cvt_pk_bf16(xn[2], xn[3]);
            s += xn[0] * xn[0] + xn[1] * xn[1] + xn[2] * xn[2] + xn[3] * xn[3];
            const f32x4 hv = xn * gm[n];
            hw[2 * n] = cvt_pk_bf16(hv[0], hv[1]); hw[2 * n + 1] = cvt_pk_bf16(hv[2], hv[3]);
        }
        if (!keep) {
            bf16_t* d = xres + (size_t)row * 1024 + tn * 128 + wc * 64 + 8 * fq;
            *(u32x4*)d = (u32x4){xb[0], xb[1], xb[2], xb[3]};
            *(u32x4*)(d + 32) = (u32x4){xb[4], xb[5], xb[6], xb[7]};
        }
        if (write_h) {
            bf16_t* d = (bf16_t*)(p.ws + WS_H) + (size_t)row * 1024 + tn * 128 + wc * 64 + 8 * fq;
            *(u32x4*)d = (u32x4){hw[0], hw[1], hw[2], hw[3]};
            *(u32x4*)(d + 32) = (u32x4){hw[4], hw[5], hw[6], hw[7]};
        }
        s += __shfl_xor(s, 16); s += __shfl_xor(s, 32);
        if (fq == 0) ((float*)(p.ws + ssq_off))[(size_t)row * 16 + tn * 2 + wc] = s;
    }
}
DI void epi_ff1(const Params& p, f32x4 (&acc)[4][4], int tm, int tn, const FoldPrep& fp) {
    const int tid = opaque_tid(), wid = tid >> 6, lane = tid & 63, wr = wid >> 1, wc = wid & 1, fr = lane & 15, fq = lane >> 4;
#pragma unroll
    for (int m = 0; m < 4; ++m) {
        const int row = tm * 256 + wr * 64 + m * 16 + fr;
        const float rstd = fp.rstd[m];
        unsigned w[8];
#pragma unroll
        for (int n = 0; n < 4; ++n) {
            f32x4 v = acc[m][n] * rstd + fp.bv[n];
#pragma unroll
            for (int j = 0; j < 4; ++j) { const float r = fmaxf(v[j], 0.f); v[j] = r * r; }
            w[2 * n] = cvt_pk_bf16(v[0], v[1]); w[2 * n + 1] = cvt_pk_bf16(v[2], v[3]);
        }
        bf16_t* d = (bf16_t*)(p.ws + WS_HBUF) + (size_t)row * 4096 + tn * 128 + wc * 64 + 8 * fq;
        *(u32x4*)d = (u32x4){w[0], w[1], w[2], w[3]};
        *(u32x4*)(d + 32) = (u32x4){w[4], w[5], w[6], w[7]};
    }
}

constexpr int N_MODL = 96;
constexpr int N_MODU = NLAYER * N_MODL;
struct TrJob { const float* src; bf16_t* dst; const float* kscale; int ld, K, k0, n0, mode, NPd; };
DI TrJob tr_job(const Params& p, int u) {
    TrJob j; unsigned char* ws = p.ws;
    const int l = u / 748; int r = u % 748; j.kscale = nullptr; j.mode = 2;
    if (r < 160) { j.src = p.in[I_WIN] + (size_t)l * 1024 * 2464; j.ld = 2464; j.dst = (bf16_t*)(ws + WS_WTIN) + (size_t)l * NIN * 1024; j.K = 1024; j.k0 = (r / 10) * 64; j.n0 = (r % 10) * 256; j.mode = 0; j.NPd = NIN; return j; }
    r -= 160;
    if (r < 8) { j.src = p.in[I_WQUP] + (size_t)l * 256 * 384; j.ld = 384; j.dst = (bf16_t*)(ws + WS_WTQUP) + (size_t)l * 384 * 256; j.K = 256; j.k0 = (r / 2) * 64; j.n0 = (r % 2) * 256; j.mode = 1; j.kscale = p.in[I_GMQ] + l * 256; j.NPd = 384; return j; }
    r -= 8;
    if (r < 4) { j.src = p.in[I_WKVUP] + (size_t)l * 128 * 512; j.ld = 512; j.dst = (bf16_t*)(ws + WS_WTKV) + (size_t)l * 512 * 128; j.K = 128; j.k0 = (r / 2) * 64; j.n0 = (r % 2) * 256; j.NPd = 512; return j; }
    r -= 4;
    if (r < 64) { j.src = p.in[I_WOUT] + (size_t)l * 1024 * 1024; j.ld = 1024; j.dst = (bf16_t*)(ws + WS_WTOUT) + (size_t)l * 1024 * 1024; j.K = 1024; j.k0 = (r / 4) * 64; j.n0 = (r % 4) * 256; j.NPd = 1024; j.mode = 3; return j; }
    r -= 64;
    if (r < 256) { j.src = p.in[I_WFF1] + (size_t)l * 1024 * 4096; j.ld = 4096; j.dst = (bf16_t*)(ws + WS_WTFF1) + (size_t)l * 4096 * 1024; j.K = 1024; j.k0 = (r / 16) * 64; j.n0 = (r % 16) * 256; j.NPd = 4096; j.mode = 3; return j; }
    r -= 256;
    j.src = p.in[I_WFF2] + (size_t)l * 4096 * 1024; j.ld = 1024; j.dst = (bf16_t*)(ws + WS_WTFF2) + (size_t)l * 1024 * 4096; j.K = 4096; j.k0 = (r / 4) * 64; j.n0 = (r % 4) * 256; j.NPd = 1024; j.mode = 3; return j;
}
DI int tr_tx(int tid) { return ((tid >> 6) << 3) | (tid & 7); }
DI int tr_ty(int tid) { return (tid >> 3) & 7; }
DI int tr_srccol(const TrJob& j, int tid) {
    const int tx = tr_tx(tid), nd = j.n0 + 4 * tx;
    int sc;
    if (j.mode == 0) { const int lg = (nd & ~31) + 8 * ((nd >> 2) & 3) + 4 * ((nd >> 4) & 1);
        if (lg < 1152) sc = lg; else if (lg < 2432) sc = lg + 32; else if (lg < 2464) sc = lg - 2432 + 1152; else sc = -1; }
    else if (j.mode == 1) { if (nd < 256) sc = (nd >> 6) * 96 + (nd & 63); else if (nd < 384) { const int r = nd - 256; sc = (r >> 5) * 96 + 64 + (r & 31); } else sc = -1; }
    else if (j.mode == 3) sc = (nd & ~31) + 8 * ((nd >> 2) & 3) + 4 * ((nd >> 4) & 1);
    else sc = nd;
    return sc;
}
DI void tr_load(const TrJob& j, f32x4 (&v)[8], int tid) {
    const int ty = tr_ty(tid);
    const int sc = tr_srccol(j, tid);
    const int scc = sc < 0 ? 0 : sc;
    const float* s = j.src + (size_t)(j.k0 + 8 * ty) * j.ld + scc;
#pragma unroll
    for (int i = 0; i < 8; ++i) v[i] = __builtin_nontemporal_load((const f32x4*)(s + (size_t)i * j.ld));
}
DI void tr_finish(const TrJob& j, f32x4 (&v)[8], int tid, LAS float* t) {
    (void)t;
    const int ty = tr_ty(tid), tx = tr_tx(tid);
    if (j.mode <= 1) {
        if (j.kscale) {
            float ks[8];
#pragma unroll
            for (int i = 0; i < 8; ++i) ks[i] = j.kscale[j.k0 + 8 * ty + i];
#pragma unroll
            for (int i = 0; i < 8; ++i) v[i] = v[i] * ks[i];
        }
        if (tr_srccol(j, tid) < 0) {
#pragma unroll
            for (int i = 0; i < 8; ++i) v[i] = (f32x4){0.f, 0.f, 0.f, 0.f};
        }
    }
    const int nd = j.n0 + 4 * tx;
    if (nd < j.NPd) {
        bf16_t* d = j.dst + (size_t)nd * j.K + j.k0 + 8 * ty;
#pragma unroll
        for (int q = 0; q < 4; ++q)
            *(u32x4*)(d + (size_t)q * j.K) = (u32x4){cvt_pk_bf16(v[0][q], v[1][q]), cvt_pk_bf16(v[2][q], v[3][q]), cvt_pk_bf16(v[4][q], v[5][q]), cvt_pk_bf16(v[6][q], v[7][q])};
    }
}
constexpr int N_TR = NLAYER * 748;
DI void transpose_all(const Params& p, int u, int ue, LAS unsigned char* lds, int jump_at = 1 << 30) {
    const int tid = opaque_tid();
    LAS float* t = (LAS float*)lds;
    f32x4 va[8], vb[8], vc[8];
    if (u >= ue) return;
#define TRID(v_) ((v_) >= jump_at ? (v_) + 256 : (v_))
    const int ul = ue - 1;
    tr_load(tr_job(p, TRID(u)), va, tid);
    tr_load(tr_job(p, TRID(min(u + 1, ul))), vb, tid);
    for (; u < ue; u += 3) {
        tr_load(tr_job(p, TRID(min(u + 2, ul))), vc, tid);
        tr_finish(tr_job(p, TRID(u)), va, tid, t);
        if (u + 1 >= ue) break;
        tr_load(tr_job(p, TRID(min(u + 3, ul))), va, tid);
        tr_finish(tr_job(p, TRID(u + 1)), vb, tid, t);
        if (u + 2 >= ue) break;
        tr_load(tr_job(p, TRID(min(u + 4, ul))), vb, tid);
        tr_finish(tr_job(p, TRID(u + 2)), vc, tid, t);
    }
#undef TRID
}
DI void transpose_one(const Params& p, int u, LAS unsigned char* lds) {
    const int tid = opaque_tid();
    f32x4 va[8];
    tr_load(tr_job(p, u), va, tid);
    tr_finish(tr_job(p, u), va, tid, (LAS float*)lds);
}

constexpr int N_CACHE_ELEMS = NLAYER * 2 * (4 * 256 * 64 * 4 + 256 * 128 + 256 * 32);
constexpr int N_CACHEU = N_CACHE_ELEMS / 4 / NT;
constexpr int N_PRO_UNITS = N_MODU + N_CACHEU + 1;

DI void prologue_unit(const Params& p, int u, LAS unsigned char* lds) {
    unsigned char* ws = p.ws;
    const int tid = opaque_tid();
    if (u < N_MODU) {
        const int l = u / N_MODL, cchunk = u % N_MODL;
        LAS float* sl = (LAS float*)lds;
        LAS float* red = sl + 3072;
        __syncthreads();
        for (int e = tid; e < 3072; e += NT) { const int seg = e >> 10, k = e & 1023; const float c = seg == 0 ? p.in[I_CCTX][k] : p.in[I_C][(seg - 1) * 1024 + k]; sl[e] = c / (1.f + __expf(-c)); }
        __syncthreads();
        const int cg = tid & 15, ks = tid >> 4;
        const int col = cchunk * 64 + cg * 4;
        const float* wm = p.in[I_WMOD] + (size_t)l * 1024 * 6144 + (size_t)(ks * 32) * 6144 + col;
        f32x4 a0 = (f32x4){0.f, 0.f, 0.f, 0.f}, a1 = a0, a2 = a0;
        {
            f32x4 w[32];
#pragma unroll
            for (int i = 0; i < 32; ++i) w[i] = __builtin_nontemporal_load((const f32x4*)(wm + (size_t)i * 6144));
#pragma unroll
            for (int i = 0; i < 32; ++i) { const int k = ks * 32 + i; a0 += w[i] * sl[k]; a1 += w[i] * sl[1024 + k]; a2 += w[i] * sl[2048 + k]; }
        }
#pragma unroll
        for (int j = 0; j < 4; ++j) { red[(ks * 16 + cg) * 12 + j] = a0[j]; red[(ks * 16 + cg) * 12 + 4 + j] = a1[j]; red[(ks * 16 + cg) * 12 + 8 + j] = a2[j]; }
        __syncthreads();
        if (tid < 192) {
            const int cgi = tid / 12, e = tid % 12;
            float s = 0.f;
#pragma unroll
            for (int k2 = 0; k2 < 32; ++k2) s += red[(k2 * 16 + cgi) * 12 + e];
            const int seg = e >> 2, c = cchunk * 64 + cgi * 4 + (e & 3);
            ((float*)(ws + WS_MOD))[((size_t)l * 3 + seg) * 6144 + c] = s + p.in[I_BMOD][(size_t)l * 6144 + c];
        }
        return;
    }
    u -= N_MODU;
    if (u < N_CACHEU) {
        const int e4 = (u * NT + tid) * 4;
        constexpr int PER_LB = 4 * 256 * 64 * 4 + 256 * 128 + 256 * 32;
        const int lb = e4 / PER_LB, r = e4 % PER_LB, l = lb >> 1, b = lb & 1;
        const float* src; bf16_t* dst;
        if (r < 4 * 65536) {
            const int which = r >> 16, off = r & 65535;
            const int ii = which == 0 ? I_CDAK : which == 1 ? I_CDAV : which == 2 ? I_CNAK : I_CNAV;
            const size_t wo = which == 0 ? WS_KCDA : which == 1 ? WS_VCDA : which == 2 ? WS_KCNA : WS_VCNA;
            src = p.in[ii] + ((size_t)(b * 2 + l)) * 65536 + off;
            dst = (bf16_t*)(ws + wo) + ((size_t)(l * 2 + b)) * 65536 + off;
        } else if (r < 4 * 65536 + 32768) {
            const int off = r - 4 * 65536;
            src = p.in[I_CCKV] + ((size_t)(b * 2 + l)) * 32768 + off;
            dst = (bf16_t*)(ws + WS_CKVA) + ((size_t)l * 8704 + 8192 + b * 256) * 128 + off;
        } else {
            const int off = r - 4 * 65536 - 32768;
            src = p.in[I_CKR] + ((size_t)(b * 2 + l)) * 8192 + off;
            dst = (bf16_t*)(ws + WS_KRC) + ((size_t)(l * 2 + b)) * 8192 + off;
        }
        store_bf16x4(dst, __builtin_nontemporal_load((const f32x4*)src));
        return;
    }
    {
        const int e = tid, pos = e >> 3, i = e & 7;
        const float ang = (float)pos * powf(10000.0f, -(float)i / 8.0f);
        ((float*)(ws + WS_ROPE))[e] = cosf(ang);
        ((float*)(ws + WS_ROPE))[512 + e] = sinf(ang);
    }
}

constexpr int N_PRE_UNITS = NTOK / 32;
DI void pre_unit(const Params& p, int unit) {
    const int tid = opaque_tid(), wid = tid >> 6, lane = tid & 63;
    const int row0 = unit * 32 + wid * 4;
    const int seg = seg_of_row(row0);
    const float* mod = (const float*)(p.ws + WS_MOD) + ((size_t)0 * 3 + seg) * 6144;
    const float* g = p.in[I_GMIX];
    f32x4 v[4][4], gg[4], s1[4], s0[4];
#pragma unroll
    for (int r = 0; r < 4; ++r) { const float* x = x_in_row(p, row0 + r);
#pragma unroll
        for (int i = 0; i < 4; ++i) v[r][i] = __builtin_nontemporal_load((const f32x4*)(x + i * 256 + lane * 4)); }
#pragma unroll
    for (int i = 0; i < 4; ++i) { const int c = i * 256 + lane * 4; gg[i] = *(const f32x4*)(g + c); s1[i] = *(const f32x4*)(mod + 1024 + c); s0[i] = *(const f32x4*)(mod + c); }
#pragma unroll
    for (int i = 0; i < 4; ++i) gg[i] = gg[i] * (s1[i] + 1.0f);
#pragma unroll
    for (int r = 0; r < 4; ++r) {
        float s = 0.f;
#pragma unroll
        for (int i = 0; i < 4; ++i) s += v[r][i][0] * v[r][i][0] + v[r][i][1] * v[r][i][1] + v[r][i][2] * v[r][i][2] + v[r][i][3] * v[r][i][3];
        s = wave_sum(s);
        const float rstd = rsqrtf(s * (1.0f / 1024.0f) + EPS);
        bf16_t* h = (bf16_t*)(p.ws + WS_H) + (size_t)(row0 + r) * 1024;
#pragma unroll
        for (int i = 0; i < 4; ++i) store_bf16x4(h + i * 256 + lane * 4, v[r][i] * rstd * gg[i] + s0[i]);
    }
}
constexpr int N_BIASU = (NIN + 2 * 4096) / 32;
DI void bias_unit(const Params& p, int unit) {
    const int tid = opaque_tid(), wid = tid >> 6, lane = tid & 63;
    const int o = (unit * 8 + wid) * 4;
    const bool is1 = o < NIN; const int l = is1 ? 1 : (o - NIN) / 4096, n = is1 ? o : (o - NIN) % 4096;
    const bf16_t* w = is1 ? (const bf16_t*)(p.ws + WS_WTIN) + ((size_t)l * NIN + n) * 1024 : (const bf16_t*)(p.ws + WS_WTFF1) + ((size_t)l * 4096 + n) * 1024;
    const float* shb = (const float*)(p.ws + WS_MOD) + (size_t)l * 3 * 6144 + (is1 ? 0 : 3) * 1024;
    float a[4][3];
#pragma unroll
    for (int q = 0; q < 4; ++q) { a[q][0] = 0.f; a[q][1] = 0.f; a[q][2] = 0.f; }
#pragma unroll
    for (int i = 0; i < 2; ++i) {
        const int k = i * 512 + lane * 8;
        bf16x8 wv[4];
#pragma unroll
        for (int q = 0; q < 4; ++q) wv[q] = *(const bf16x8*)(w + (size_t)q * 1024 + k);
        f32x4 s0[2], s1[2], s2[2];
#pragma unroll
        for (int hh = 0; hh < 2; ++hh) { s0[hh] = *(const f32x4*)(shb + k + 4 * hh); s1[hh] = *(const f32x4*)(shb + 6144 + k + 4 * hh); s2[hh] = *(const f32x4*)(shb + 2 * 6144 + k + 4 * hh); }
#pragma unroll
        for (int q = 0; q < 4; ++q)
#pragma unroll
            for (int e = 0; e < 8; ++e) { const float wf = bf2f((bf16_t)wv[q][e]); a[q][0] += wf * s0[e >> 2][e & 3]; a[q][1] += wf * s1[e >> 2][e & 3]; a[q][2] += wf * s2[e >> 2][e & 3]; }
    }
    const int nact = (n & ~31) + 8 * ((n >> 2) & 3) + 4 * ((n >> 4) & 1);
    float* b = is1 ? (float*)(p.ws + WS_BIAS1) + (size_t)l * 3 * NIN + nact : (float*)(p.ws + WS_BIAS2) + (size_t)l * 3 * 4096 + nact;
    const int st = is1 ? NIN : 4096;
#pragma unroll
    for (int q = 0; q < 4; ++q) {
        const float r0 = wave_sum(a[q][0]), r1 = wave_sum(a[q][1]), r2 = wave_sum(a[q][2]);
        if (lane == 0) { b[q] = r0; b[st + q] = r1; b[2 * st + q] = r2; }
    }
}

DI void final_from_regs(const Params& p, const f32x4 (&xn)[4][4], int tm, int tn) {
    const int tid = opaque_tid(), wid = tid >> 6, lane = tid & 63, wr = wid >> 1, wc = wid & 1, fr = lane & 15, fq = lane >> 4;
    f32x4 gf[4], sp[4];
#pragma unroll
    for (int n = 0; n < 4; ++n) gf[n] = *(const f32x4*)(p.in[I_GFIN] + tn * 128 + wc * 64 + ecol(n, fq, true));
#pragma unroll
    for (int m = 0; m < 4; ++m) sp[m] = *(const f32x4*)((const float*)(p.ws + WS_SSQ1) + (size_t)(tm * 256 + wr * 64 + m * 16 + fr) * 16 + 4 * fq);
#pragma unroll
    for (int m = 0; m < 4; ++m) {
        float t = (sp[m][0] + sp[m][1]) + (sp[m][2] + sp[m][3]); t += __shfl_xor(t, 16); t += __shfl_xor(t, 32);
        const float rstd = rsqrtf(t * (1.0f / 1024.0f) + EPS);
        float* y = p.out + (size_t)(tm * 256 + wr * 64 + m * 16 + fr) * 1024 + tn * 128 + wc * 64;
#pragma unroll
        for (int n = 0; n < 4; ++n) *(f32x4*)(y + ecol(n, fq, true)) = xn[m][n] * rstd * gf[n];
    }
}

DI s16x4 lds_tr16(LAS const unsigned char* p) { return __builtin_bit_cast(s16x4, __builtin_amdgcn_ds_read_tr16_b64_v4i16((LAS s16x4*)p)); }
constexpr int AT_K = 0, AT_R = 16384, AT_V = 24576, AT_BUF = 40960, AT_RPB = 3 * AT_BUF;

struct TileSrc { const unsigned char* k; const unsigned char* v; const unsigned char* r; int pk, pv, pr; };

template <int MODE>
DI TileSrc attn_tile_src(const Params& p, int l, int b, int hh, bool lat, int own0, int na_rs, int t) {
    unsigned char* ws = p.ws; TileSrc s; s.r = nullptr; s.pr = 0;
    const int nct = lat ? 2 : 0;
    if (t < nct) {
        if (MODE == 1) {
            const size_t krow = 8192 + b * 256 + t * 128;
            s.k = ws + WS_KVM + (krow * 512 + hh * 128) * 2; s.v = s.k + 128; s.pk = s.pv = 1024;
            s.r = ws + WS_KRC + ((size_t)(l * 2 + b) * 256 + t * 128) * 64; s.pr = 64;
        } else {
            const size_t off = ((((size_t)(l * 2 + b) * 4 + hh) * 256) + t * 128) * 128;
            s.k = ws + (MODE == 0 ? WS_KCDA : WS_KCNA) + off; s.v = ws + (MODE == 0 ? WS_VCDA : WS_VCNA) + off; s.pk = s.pv = 128;
        }
    } else {
        const int a = t - nct;
        const size_t row = own0 + (size_t)((MODE == 2 && lat) ? (na_rs + 2 * a) : 2 * a) * 64;
        if (MODE == 1) {
            s.k = ws + WS_KVM + (row * 512 + hh * 128) * 2; s.v = s.k + 128; s.pk = s.pv = 1024;
            s.r = ws + WS_KRA + row * 64; s.pr = 64;
        } else {
            s.k = ws + (MODE == 0 ? WS_KDA : WS_KNA) + (row * 256 + hh * 64) * 2; s.v = ws + (MODE == 0 ? WS_VDA : WS_VNA) + (row * 256 + hh * 64) * 2; s.pk = s.pv = 512;
        }
    }
    return s;
}

template <int MODE>
DI void attn_unit(const Params& p, int l, int b, int hh, bool lat, int q0tok, int own0, int ntiles, int na_r0, LAS unsigned char* lds) {
    const int tid = opaque_tid(), wv = tid >> 6, lane = tid & 63, g = lane >> 4, c = lane & 15;
    unsigned char* ws = p.ws;
    constexpr int NMAP = (MODE == 0) ? 2 : 1;
    constexpr int NKS = (MODE == 0) ? 1 : (MODE == 1 ? 3 : 2);
    const float scale = (MODE == 0) ? 0.17677669529663687f : (MODE == 1 ? 0.10206207261596577f : 0.125f);
    const float c1 = scale * LOG2E;
    const bool na_loc = (MODE == 2 && lat);
    const int na_rsA = na_loc ? min(max(na_r0 - 4, 0), 24) : 0;
    const int na_r = na_r0 + (wv >> 2);
    const int na_rs = na_loc ? min(max(na_r - 4, 0), 24) : 0;
    const int qtok = q0tok + wv * 16 + c;
    bf16x8 qf[NMAP][NKS];
    if (MODE == 0) {
        const bf16_t* q = (const bf16_t*)(ws + WS_QDA) + (size_t)qtok * 256 + hh * 64;
        qf[0][0] = *(const bf16x8*)(q + 8 * g); qf[NMAP - 1][0] = *(const bf16x8*)(q + 32 + 8 * g);
    } else if (MODE == 1) {
        const bf16_t* q = (const bf16_t*)(ws + WS_QM) + (size_t)qtok * 384;
        qf[0][0] = *(const bf16x8*)(q + hh * 64 + 8 * g); qf[0][1 % NKS] = *(const bf16x8*)(q + hh * 64 + 32 + 8 * g); qf[0][2 % NKS] = *(const bf16x8*)(q + 256 + hh * 32 + 8 * g);
    } else {
        const bf16_t* q = (const bf16_t*)(ws + WS_QNA) + (size_t)qtok * 256 + hh * 64;
        qf[0][0] = *(const bf16x8*)(q + 8 * g); qf[0][1 % NKS] = *(const bf16x8*)(q + 32 + 8 * g);
    }
    const int rowA = tid >> 3, chA = tid & 7, rowB = rowA + 64;
    const int kdstA = rowA * 128 + ((chA ^ ((rowA >> 1) & 7)) << 4), kdstB = rowB * 128 + ((chA ^ ((rowB >> 1) & 7)) << 4);
    const int vdstA = rowA * 128 + ((chA ^ (((rowA >> 1) & 3) << 1)) << 4), vdstB = rowB * 128 + ((chA ^ (((rowB >> 1) & 3) << 1)) << 4);
    const int rrow = tid >> 2, rch = tid & 3, rdst = rrow * 64 + ((rch ^ ((-(rrow >> 2)) & 3)) << 4);
    u32x4 rk0, rk1, rv0, rv1, rr0;
    rr0 = (u32x4){0u, 0u, 0u, 0u};
#define AT_LOAD(t_) do { const TileSrc s_ = attn_tile_src<MODE>(p, l, b, hh, lat, own0, na_rsA, (t_)); \
        rk0 = *(const u32x4*)(s_.k + (size_t)rowA * s_.pk + chA * 16); rk1 = *(const u32x4*)(s_.k + (size_t)rowB * s_.pk + chA * 16); \
        rv0 = *(const u32x4*)(s_.v + (size_t)rowA * s_.pv + chA * 16); rv1 = *(const u32x4*)(s_.v + (size_t)rowB * s_.pv + chA * 16); \
        if (MODE == 1) rr0 = *(const u32x4*)(s_.r + (size_t)rrow * s_.pr + rch * 16); } while (0)
#define AT_WRITE(buf_) do { LAS unsigned char* d_ = lds + (buf_) * AT_BUF; \
        *(LAS u32x4*)(d_ + AT_K + kdstA) = rk0; *(LAS u32x4*)(d_ + AT_K + kdstB) = rk1; \
        *(LAS u32x4*)(d_ + AT_V + vdstA) = rv0; *(LAS u32x4*)(d_ + AT_V + vdstB) = rv1; \
        if (MODE == 1) *(LAS u32x4*)(d_ + AT_R + rdst) = rr0; } while (0)
    __syncthreads();
    if (na_loc) {
        const float* rpb = p.in[I_RPB] + ((size_t)l * 4 + hh) * 465;
        if (tid < 465) ((LAS float*)(lds + AT_RPB))[tid] = rpb[tid] * LOG2E;
    }
    AT_LOAD(0); AT_WRITE(0);
    if (ntiles > 1) AT_LOAD(1);
    __syncthreads();
    const int ksw = (c >> 1) & 7;
    const int koff0 = c * 128 + ((g ^ ksw) << 4), koff1 = c * 128 + (((4 + g) ^ ksw) << 4);
    const int roff = c * 64 + ((g ^ ((-(c >> 2)) & 3)) << 4);
    const int vq = c >> 2, vpp = c & 3;
    const int vrow0 = 4 * g + vq;
    const int vsw = ((vrow0 >> 1) & 3) << 1;
    float m_run[NMAP];
    f32x4 o[NMAP][4], ol[NMAP];
#pragma unroll
    for (int mp = 0; mp < NMAP; ++mp) { m_run[mp] = -1e30f; ol[mp] = (f32x4){0.f, 0.f, 0.f, 0.f};
#pragma unroll
        for (int n = 0; n < 4; ++n) o[mp][n] = (f32x4){0.f, 0.f, 0.f, 0.f}; }
    const int wq = (wv & 3) * 16 + c;
    const int na_cs = min(max(wq - 8, 0), 48);
    bf16x8 ones;
#pragma unroll
    for (int e = 0; e < 8; ++e) ones[e] = (short)0x3F80;
    const bool late = __builtin_amdgcn_readfirstlane(wv) >= 4;
    int bcur = 0;
    for (int t = 0; t < ntiles; ++t) {
        const int bnx = bcur == 2 ? 0 : bcur + 1;
        if (t + 1 < ntiles) AT_WRITE(bnx);
        if (t + 2 < ntiles) AT_LOAD(t + 2);
        const bool loc_tile = na_loc && t >= 2;
        const int krow0 = na_rsA + 2 * (t - 2);
        LAS const unsigned char* kb = lds + bcur * AT_BUF + AT_K;
        LAS const unsigned char* rb = lds + bcur * AT_BUF + AT_R;
        LAS const unsigned char* vb = lds + bcur * AT_BUF + AT_V;
        bf16x8 pf[NMAP][4];
#pragma unroll
        for (int mp = 0; mp < NMAP; ++mp) {
            f32x4 s[8];
#pragma unroll
            for (int blk = 0; blk < 8; ++blk) {
                f32x4 a = (f32x4){0.f, 0.f, 0.f, 0.f};
                if (MODE == 0) {
                    const bf16x8 kf = *(LAS const bf16x8*)(kb + blk * 2048 + (mp == 0 ? koff0 : koff1));
                    a = __builtin_amdgcn_mfma_f32_16x16x32_bf16(kf, qf[mp][0], a, 0, 0, 0);
                } else {
                    const bf16x8 kf0 = *(LAS const bf16x8*)(kb + blk * 2048 + koff0), kf1 = *(LAS const bf16x8*)(kb + blk * 2048 + koff1);
                    a = __builtin_amdgcn_mfma_f32_16x16x32_bf16(kf0, qf[0][0], a, 0, 0, 0);
                    a = __builtin_amdgcn_mfma_f32_16x16x32_bf16(kf1, qf[0][1 % NKS], a, 0, 0, 0);
                    if (MODE == 1) { const bf16x8 kf2 = *(LAS const bf16x8*)(rb + blk * 1024 + roff); a = __builtin_amdgcn_mfma_f32_16x16x32_bf16(kf2, qf[0][2 % NKS], a, 0, 0, 0); }
                }
                s[blk] = a;
            }
            if (loc_tile) {
#pragma unroll
                for (int hf = 0; hf < 2; ++hf) {
                    const int krow = krow0 + hf;
                    const bool rin = (krow >= na_rs) && (krow < na_rs + 8);
                    const int dr = min(max(krow - na_r + 7, 0), 14);
                    LAS const float* brow = (LAS const float*)(lds + AT_RPB) + dr * 31;
#pragma unroll
                    for (int bq = 0; bq < 4; ++bq)
#pragma unroll
                        for (int i = 0; i < 4; ++i) {
                            const int wk = 16 * bq + 4 * g + i;
                            const bool ok = rin && (wk >= na_cs) && (wk < na_cs + 16);
                            const int idx = min(max(wk - wq + 15, 0), 30);
                            s[hf * 4 + bq][i] = ok ? (s[hf * 4 + bq][i] * c1 + brow[idx]) : -INFINITY;
                        }
                }
            }
            const float esc = loc_tile ? 1.0f : c1;
            float mx = fmaxf(s[0][0], s[0][1]), mx2 = fmaxf(s[0][2], s[0][3]);
#pragma unroll
            for (int blk = 1; blk < 8; ++blk) { mx = fmaxf(fmaxf(mx, s[blk][0]), s[blk][1]); mx2 = fmaxf(fmaxf(mx2, s[blk][2]), s[blk][3]); }
            mx = fmaxf(mx, mx2);
            mx = xmax32(xmax16(mx));
            const float mn = fmaxf(m_run[mp], mx * esc);
            if (__any(mn != m_run[mp])) {
                const float alpha = __builtin_amdgcn_exp2f(m_run[mp] - mn);
#pragma unroll
                for (int n = 0; n < 4; ++n) o[mp][n] = o[mp][n] * alpha;
                ol[mp] = ol[mp] * alpha;
            }
            m_run[mp] = mn;
            {
                const f32x4 escv = (f32x4){esc, esc, esc, esc}, nmn = (f32x4){-mn, -mn, -mn, -mn};
#pragma unroll
                for (int blk = 0; blk < 8; ++blk) {
                    const f32x4 a = __builtin_elementwise_fma(s[blk], escv, nmn);
#pragma unroll
                    for (int i = 0; i < 4; ++i) s[blk][i] = __builtin_amdgcn_exp2f(a[i]);
                }
            }
#pragma unroll
            for (int sidx = 0; sidx < 4; ++sidx) {
                u32x4 w;
                w.x = cvt_pk_bf16(s[2 * sidx][0], s[2 * sidx][1]); w.y = cvt_pk_bf16(s[2 * sidx][2], s[2 * sidx][3]);
                w.z = cvt_pk_bf16(s[2 * sidx + 1][0], s[2 * sidx + 1][1]); w.w = cvt_pk_bf16(s[2 * sidx + 1][2], s[2 * sidx + 1][3]);
                pf[mp][sidx] = __builtin_bit_cast(bf16x8, w);
            }
        }
        if (late) __syncthreads();
#pragma unroll
        for (int mp = 0; mp < NMAP; ++mp)
#pragma unroll
            for (int sidx = 0; sidx < 4; ++sidx) ol[mp] = __builtin_amdgcn_mfma_f32_16x16x32_bf16(ones, pf[mp][sidx], ol[mp], 0, 0, 0);
#pragma unroll
        for (int sidx = 0; sidx < 4; ++sidx)
#pragma unroll
            for (int n = 0; n < 4; ++n) {
                const int chunk = (2 * n + (vpp >> 1)) ^ vsw;
                LAS const unsigned char* va = vb + (32 * sidx + vrow0) * 128 + (chunk << 4) + (vpp & 1) * 8;
                const s16x4 lo = lds_tr16(va), hi = lds_tr16(va + 16 * 128);
                bf16x8 vf; vf[0] = lo[0]; vf[1] = lo[1]; vf[2] = lo[2]; vf[3] = lo[3]; vf[4] = hi[0]; vf[5] = hi[1]; vf[6] = hi[2]; vf[7] = hi[3];
#pragma unroll
                for (int mp = 0; mp < NMAP; ++mp) o[mp][n] = __builtin_amdgcn_mfma_f32_16x16x32_bf16(vf, pf[mp][sidx], o[mp][n], 0, 0, 0);
            }
        if (!late) __syncthreads();
        bcur = bnx;
    }
#undef AT_LOAD
#undef AT_WRITE
    float inv[NMAP];
#pragma unroll
    for (int mp = 0; mp < NMAP; ++mp) inv[mp] = 1.0f / ol[mp][0];
    bf16_t* mix = (bf16_t*)(ws + WS_MIX) + (size_t)qtok * 1024 + MODE * 256 + hh * 64;
    if (MODE == 0) {
        float e1 = 0.f, e2 = 0.f;
        for (int i = 0; i < 32; ++i) { e1 += p.in[I_LQ1][l * 32 + i] * p.in[I_LK1][l * 32 + i]; e2 += p.in[I_LQ2][l * 32 + i] * p.in[I_LK2][l * 32 + i]; }
        const float lam_init = 0.8f - 0.6f * expf(-0.3f * (float)l);
        const float lam = expf(e1) - expf(e2) + lam_init;
        f32x4 r[4]; float ss = 0.f;
#pragma unroll
        for (int n = 0; n < 4; ++n) { r[n] = o[0][n] * inv[0] - o[NMAP - 1][n] * (lam * inv[NMAP - 1]); ss += r[n][0] * r[n][0] + r[n][1] * r[n][1] + r[n][2] * r[n][2] + r[n][3] * r[n][3]; }
        ss += __shfl_xor(ss, 16); ss += __shfl_xor(ss, 32);
        const float rs = rsqrtf(ss * (1.0f / 64.0f) + EPS) * (1.0f - lam_init);
#pragma unroll
        for (int n = 0; n < 4; ++n) { const f32x4 gs = *(const f32x4*)(p.in[I_GSUB] + l * 64 + 16 * n + 4 * g); store_bf16x4(mix + 16 * n + 4 * g, r[n] * rs * gs); }
    } else {
#pragma unroll
        for (int n = 0; n < 4; ++n) store_bf16x4(mix + 16 * n + 4 * g, o[0][n] * inv[0]);
    }
}

DI void conv_unit(const Params& p, int l, int cu, LAS unsigned char* lds) {
    const int tid = opaque_tid(), c = tid & 255, th = tid >> 8, wid = tid >> 6, lane = tid & 63;
    unsigned char* ws = p.ws;
    const int t0 = cu * 64;
    const bool lat = t0 >= 4096;
    const int seq0 = lat ? 4096 + ((t0 - 4096) >> 11) * 2048 : (t0 >> 8) * 256, seqlen = lat ? 2048 : 256;
    const bf16_t* CU = (const bf16_t*)(ws + WS_CU);
    LAS float* gl = (LAS float*)lds;
    __syncthreads();
    bf16x8 av[6], bv[6];
#pragma unroll
    for (int q = 0; q < 6; ++q) {
        const int ch = q * NT + tid, i = min(ch >> 5, 93), cc = (ch & 31) * 8;
        const int s = t0 - seq0 + i - 15, sc_ = min(max(s, 0), seqlen - 1);
        const bf16_t* r = CU + (size_t)(seq0 + sc_) * 512 + cc;
        av[q] = *(const bf16x8*)r; bv[q] = *(const bf16x8*)(r + 256);
    }
#pragma unroll
    for (int q = 0; q < 6; ++q) {
        const int ch = q * NT + tid, i = ch >> 5, cc = (ch & 31) * 8;
        if (i < 94) {
            const int s = t0 - seq0 + i - 15;
            const bool ok = (s >= 0 && s < seqlen);
            f32x4 g0, g1;
#pragma unroll
            for (int e = 0; e < 4; ++e) {
                const float a0 = bf2f((bf16_t)av[q][e]), b0 = bf2f((bf16_t)bv[q][e]), a1 = bf2f((bf16_t)av[q][4 + e]), b1 = bf2f((bf16_t)bv[q][4 + e]);
                g0[e] = ok ? a0 * __builtin_amdgcn_rcpf(1.f + __expf(-b0)) : 0.f; g1[e] = ok ? a1 * __builtin_amdgcn_rcpf(1.f + __expf(-b1)) : 0.f;
            }
            *(LAS f32x4*)(gl + i * 256 + cc) = g0; *(LAS f32x4*)(gl + i * 256 + cc + 4) = g1;
        }
    }
    float w[31];
#pragma unroll
    for (int j = 0; j < 31; ++j) w[j] = p.in[I_CDW][((size_t)l * 31 + j) * 256 + c];
    const float bias = p.in[I_CB][l * 256 + c];
    __syncthreads();
    float yv[32];
#pragma unroll 1
    for (int half = 0; half < 2; ++half) {
        float g[46];
#pragma unroll
        for (int i = 0; i < 46; ++i) g[i] = gl[(th * 32 + half * 16 + i) * 256 + c];
#pragma unroll
        for (int i = 0; i < 16; ++i) {
            float a = bias;
#pragma unroll
            for (int j = 0; j < 31; ++j) a += g[i + j] * w[j];
            if (half == 0) yv[i] = a; else yv[16 + i] = a;
        }
    }
    __syncthreads();
#pragma unroll
    for (int i = 0; i < 32; ++i) gl[(th * 32 + i) * 256 + c] = yv[i];
    __syncthreads();
    const f32x4 lg = *(const f32x4*)(p.in[I_CLG] + l * 256 + lane * 4), lb = *(const f32x4*)(p.in[I_CLB] + l * 256 + lane * 4);
    for (int i = wid * 8; i < wid * 8 + 8; ++i) {
        f32x4 v = *(LAS const f32x4*)(gl + i * 256 + lane * 4);
        const float mu = wave_sum(v[0] + v[1] + v[2] + v[3]) * (1.0f / 256.0f);
        const f32x4 d = v - mu;
        const float var = wave_sum(d[0] * d[0] + d[1] * d[1] + d[2] * d[2] + d[3] * d[3]) * (1.0f / 256.0f);
        const float rstd = rsqrtf(var + EPS);
        f32x4 o = d * rstd * lg + lb;
#pragma unroll
        for (int j = 0; j < 4; ++j) o[j] = o[j] * __builtin_amdgcn_rcpf(1.f + __expf(-o[j]));
        store_bf16x4((bf16_t*)(ws + WS_MIX) + (size_t)(t0 + i) * 1024 + 768 + lane * 4, o);
    }
}

constexpr int N_MIX_UNITS = 1280;
DI void ctx_attn(const Params& p, int l, int mode, int r, LAS unsigned char* lds) {
    const int b = r >> 3, hh = (r >> 1) & 3, qb = r & 1;
    const int own0 = b * 256, q0 = own0 + qb * 128;
    if (mode == 0) attn_unit<0>(p, l, b, hh, false, q0, own0, 2, -1, lds);
    else if (mode == 1) attn_unit<1>(p, l, b, hh, false, q0, own0, 2, -1, lds);
    else attn_unit<2>(p, l, b, hh, false, q0, own0, 2, -1, lds);
}
DI void mixer_unit(const Params& p, int l, int u, LAS unsigned char* lds) {
    if (u < 384) {
        const int mode = u >> 7, r0 = u & 127, r = ((r0 & 7) << 4) | (r0 >> 3), b = r >> 6, hh = (r >> 4) & 3, qb = r & 15;
        const int own0 = 4096 + b * 2048, q0 = own0 + qb * 128;
        if (mode == 0) attn_unit<0>(p, l, b, hh, true, q0, own0, 18, -1, lds);
        else if (mode == 1) attn_unit<1>(p, l, b, hh, true, q0, own0, 18, -1, lds);
        else { const int r0 = 2 * qb, rsA = min(max(r0 - 4, 0), 24), rsB = min(max(r0 - 3, 0), 24); attn_unit<2>(p, l, b, hh, true, q0, own0, 2 + 4 + (rsB - rsA), r0, lds); }
    } else if (u < 512) conv_unit(p, l, u - 384, lds);
    else if (u >= 640 && u < 768) ctx_attn(p, l, 0, u - 640, lds);
    else if (u >= 896 && u < 1024) ctx_attn(p, l, 1, u - 896, lds);
    else if (u >= 1152) ctx_attn(p, l, 2, u - 1152, lds);
}

#define XB_TMO      128
#define XB_XCNT(j)  (256  + 64 * (j))
#define XB_SPIN_CAP (1u << 20)
DI unsigned xb_ld(unsigned* p) { return __hip_atomic_load(p, __ATOMIC_RELAXED, __HIP_MEMORY_SCOPE_AGENT); }
DI unsigned xb_add(unsigned* p, unsigned v) { return __hip_atomic_fetch_add(p, v, __ATOMIC_RELAXED, __HIP_MEMORY_SCOPE_AGENT); }
DI unsigned xb_xcc_id() { return (unsigned)__builtin_amdgcn_s_getreg((3 << 11) | 20) & 0xFu; }
#define XB_SPIN(cond, bar) do { unsigned _sp = 0; while (cond) { __builtin_amdgcn_s_sleep(1); \
    if ((++_sp & 255u) == 0u) { if (xb_ld(&(bar)[XB_TMO])) break; if (_sp > XB_SPIN_CAP) { atomicAdd(&(bar)[XB_TMO], 1u); break; } } } } while (0)
struct XcdBarrier { unsigned* bar; unsigned x; volatile LAS unsigned* st; };
DI XcdBarrier xcd_barrier_post(unsigned* bar, volatile LAS unsigned* st) {
    XcdBarrier b; b.bar = bar; b.x = xb_xcc_id(); b.st = st;
    if (threadIdx.x == 0) (void)xb_add(&bar[XB_XCNT(b.x)], 1u);
    return b;
}
DI void xcd_barrier_complete(unsigned* bar, unsigned x, unsigned& nloc, unsigned& nx) {
    const unsigned G = gridDim.x;
    unsigned sum, cnt, mine, sp = 0u;
    for (;;) {
        sum = 0u; cnt = 0u; mine = 0u;
#pragma unroll
        for (unsigned j = 0; j < 16; ++j) { const unsigned c = xb_ld(&bar[XB_XCNT(j)]); sum += c; cnt += (c > 0u) ? 1u : 0u; mine = (j == x) ? c : mine; }
        if (sum == G) break;
        __builtin_amdgcn_s_sleep(1);
        if ((++sp & 255u) == 0u) { if (xb_ld(&bar[XB_TMO])) break; if (sp > XB_SPIN_CAP) { atomicAdd(&bar[XB_TMO], 1u); break; } }
    }
    nloc = mine > 0u ? mine : 1u; nx = cnt > 0u ? cnt : 1u;
}

#define XB_XSUB2(c, j) ((c) == 0 ? 3456 + 32 * (j) : (c) == 1 ? 5632 + 32 * (j) : 6400 + 32 * (j))
#define XB_TOP2(c)     ((c) == 0 ? 4000 : (c) == 1 ? 6176 : 6944)
DI void xcd_arrive2(unsigned* bar, unsigned x, volatile LAS unsigned* st, int ch = 0) {
    asm volatile("s_waitcnt vmcnt(0)" ::: "memory");
    __syncthreads();
    if (threadIdx.x == 0) {
        __builtin_amdgcn_s_waitcnt(0);
        unsigned nloc = st[0], nx = st[1];
        if (nloc == 0u) { xcd_barrier_complete(bar, x, nloc, nx); st[0] = nloc; st[1] = nx; }
        const unsigned old = xb_add(&bar[XB_XSUB2(ch, x)], 1u);
        if ((old + 1u) % nloc == 0u) {
            __builtin_amdgcn_fence(__ATOMIC_RELEASE, "agent");
            asm volatile("s_waitcnt vmcnt(0)" ::: "memory");
            xb_add(&bar[XB_TOP2(ch)], 1u);
        }
    }
}
DI void xcd_wait2(unsigned* bar, volatile LAS unsigned* st, unsigned epoch, int ch = 0) {
    if (threadIdx.x == 0) {
        const unsigned want = st[1] * (epoch + 1u);
        XB_SPIN(xb_ld(&bar[XB_TOP2(ch)]) < want, bar);
        __builtin_amdgcn_fence(__ATOMIC_ACQUIRE, "agent");
        asm volatile("s_waitcnt vmcnt(0)" ::: "memory");
    }
    __syncthreads();
}

#define GB_FLAG(g) (4096 + 32 * (g))
#define GB_CNT(g)  (4096 + 32 * (g) + 16)
#define GB_XCC(b)  (5120 + (b))
DI void grp_barrier(unsigned* bar, int grp, int mem, unsigned epoch, bool local) {
    asm volatile("s_waitcnt vmcnt(0)" ::: "memory");
    __syncthreads();
    if (threadIdx.x == 0) {
        const unsigned want = epoch + 1u;
        if (local) {
            unsigned* fl = bar + GB_FLAG(grp);
            asm volatile("global_store_dword %0, %1, off sc0\n\ts_waitcnt vmcnt(0)" :: "v"(fl + mem), "v"(want) : "memory");
            unsigned sp = 0;
            for (;;) {
                u32x4 a, b;
                asm volatile("global_load_dwordx4 %0, %2, off sc1\n\tglobal_load_dwordx4 %1, %2, off offset:16 sc1\n\ts_waitcnt vmcnt(0)" : "=&v"(a), "=&v"(b) : "v"(fl) : "memory");
                const unsigned mn = min(min(min(a[0], a[1]), min(a[2], a[3])), min(min(b[0], b[1]), min(b[2], b[3])));
                if (mn >= want) break;
                __builtin_amdgcn_s_sleep(1);
                if ((++sp & 255u) == 0u) { if (xb_ld(&bar[XB_TMO])) break; if (sp > XB_SPIN_CAP) { atomicAdd(&bar[XB_TMO], 1u); break; } }
            }
        } else {
            __builtin_amdgcn_fence(__ATOMIC_RELEASE, "agent"); asm volatile("s_waitcnt vmcnt(0)" ::: "memory");
            (void)xb_add(&bar[GB_CNT(grp)], 1u);
            XB_SPIN(xb_ld(&bar[GB_CNT(grp)]) < 8u * want, bar);
        }
        __builtin_amdgcn_fence(__ATOMIC_ACQUIRE, "agent");
        asm volatile("s_waitcnt vmcnt(0)" ::: "memory");
    }
    __syncthreads();
}

constexpr int N_PHASES = 11;
typedef const unsigned char __attribute__((address_space(4)))* kaptr_t;
#define FRESH_PARAMS(pp) kaptr_t ka_ = (kaptr_t)__builtin_amdgcn_kernarg_segment_ptr(); asm volatile("" : "+s"(ka_)); const Params& pp = *(const Params*)ka_

__global__ void __launch_bounds__(NT, 2) mk_fwd(Params p_, int ph_lo, int ph_hi) {
    extern __shared__ __attribute__((aligned(16))) unsigned char smem[];
    LAS unsigned char* lds = (LAS unsigned char*)smem;
    const int G = gridDim.x, bid = blockIdx.x;
    volatile LAS unsigned* bst = (volatile LAS unsigned*)(lds + LDS_MAIN);
    const bool multi = (ph_hi - ph_lo) > 1;
    unsigned xcc = 0;
    if (multi) {
        if (threadIdx.x == 0) { bst[0] = 0u; bst[1] = 0u; }
        __syncthreads();
        xcc = __builtin_amdgcn_readfirstlane(xcd_barrier_post((unsigned*)(p_.ws + WS_BAR), bst).x);
        if (threadIdx.x == 0) (void)xb_add((unsigned*)(p_.ws + WS_BAR) + GB_XCC(bid), xcc + 1u);
    }
    const int grp = (bid & 7) * 4 + (bid >> 6), mem = (bid >> 3) & 7;
    bool glocal = false;
    unsigned gep = 0u;
    for (int ph = ph_lo; ph < ph_hi; ++ph) {
        if (ph == 0) {
            if (bid < N_MODU) { FRESH_PARAMS(p); prologue_unit(p, bid, lds); }
            if (multi) { FRESH_PARAMS(pb); xcd_arrive2((unsigned*)(pb.ws + WS_BAR), xcc, bst); }
            { const int ob = opaque_bid(); FRESH_PARAMS(p); if (ob >= 192) transpose_all(p, 2 * (ob - 192), 2 * (ob - 192) + 2, lds); else if (ob < 44) transpose_one(p, 128 + ob, lds); }
            for (int u = N_MODU + ((bid + 64) % G); u < N_PRO_UNITS; u += G) { FRESH_PARAMS(p); prologue_unit(p, u, lds); }
            if (multi) { FRESH_PARAMS(pb); xcd_arrive2((unsigned*)(pb.ws + WS_BAR), xcc, bst, 1); }
            if (multi) { FRESH_PARAMS(pb); xcd_wait2((unsigned*)(pb.ws + WS_BAR), bst, 0u);
                unsigned same = 1u;
                for (int m2 = 0; m2 < 8; ++m2) same &= (xb_ld((unsigned*)(pb.ws + WS_BAR) + GB_XCC((bid & 7) + 8 * (8 * (bid >> 6) + m2))) == xcc + 1u) ? 1u : 0u;
                glocal = __builtin_amdgcn_readfirstlane(same) != 0u; }
            { FRESH_PARAMS(p); pre_unit(p, multi ? grp * 8 + mem : bid); }
        } else {
            const int l = (ph - 1) / 5, sub5 = (ph - 1) % 5, sub = sub5 == 0 ? 0 : sub5 + 1;
            if (ph == 1 && multi) { FRESH_PARAMS(pb); xcd_wait2((unsigned*)(pb.ws + WS_BAR), bst, 0u, 1); }
            if (sub == 0) {
                const bf16_t* A = (const bf16_t*)(p_.ws + WS_H); const bf16_t* Bt = (const bf16_t*)(p_.ws + WS_WTIN) + (size_t)l * NIN * 1024;
                FoldPrep fc; const int tm = grp; int tn = mem;
                const int nt = mem < 4 ? 3 : 2;
                { FRESH_PARAMS(p);
                    gemm_prefetch(A, Bt, 1024, tm * 256, tn * 128, lds);
                    if (l > 0) fold_prep(fc, (const float*)(p.ws + WS_BIAS1) + ((size_t)l * 3 + seg_of_row(tm * 256)) * NIN, (const float*)(p.ws + WS_SSQ1), tm, tn, true); }
                for (int r = 0; r < nt; ++r) { FRESH_PARAMS(p); f32x4 acc[4][4];
                    gemm_tile(A, Bt, 1024, tm * 256, tn * 128, lds, acc);
                    const bool nx = r + 1 < nt; const int tn2 = tn + 8;
                    if (nx) gemm_prefetch(A, Bt, 1024, tm * 256, tn2 * 128, lds);
                    epi_inproj(p, l, acc, tm, tn, lds, fc);
                    if (nx && l > 0) fold_prep(fc, (const float*)(p.ws + WS_BIAS1) + ((size_t)l * 3 + seg_of_row(tm * 256)) * NIN, (const float*)(p.ws + WS_SSQ1), tm, tn2, true);
                    tn = tn2;
                }
                { const int ob = opaque_bid(); const int og = (ob & 7) * 4 + (ob >> 6), om = (ob >> 3) & 7; FRESH_PARAMS(p);
                  int first = 0, cnt = 0, extra = -1;
                  if (l == 0) { const int b0 = 172 + 15 * og;
                      if (om == 4) { first = b0; cnt = 4; } else if (om == 5) { first = b0 + 4; cnt = 3; } else if (om == 6) { first = b0 + 7; cnt = 4; }
                      else if (om == 7) { first = b0 + 11; cnt = 4; if (og < 12) extra = 908 + og; }
                  } else { const int b0 = 920 + 10 * og;
                      if (om == 4) { first = b0; cnt = 2; } else if (om == 5) { first = b0 + 2; cnt = 2; } else if (om == 6) { first = b0 + 4; cnt = 3; }
                      else if (om == 7) { first = b0 + 7; cnt = 3; } }
                  if (cnt > 0) transpose_all(p, first, first + cnt, lds, l == 0 ? 492 : (1 << 30));
                  if (extra >= 0) transpose_one(p, extra, lds); }
            } else if (sub == 2) {
                { const int om = (opaque_bid() >> 3) & 7, og = (opaque_bid() & 7) * 4 + (opaque_bid() >> 6);
                  const int u = om < 3 ? og * 3 + om : om < 7 ? 96 + og * 4 + (om - 3) : og < 8 ? 96 + 128 + og : 232;
                  if (u < 232) { FRESH_PARAMS(p); f32x4 acc[4][4];
                      const bool isq = u < 96; const int v = u - 96;
                      const bf16_t* A = isq ? (const bf16_t*)(p.ws + WS_QD) : (const bf16_t*)(p.ws + WS_CKVA) + (size_t)l * 8704 * 128;
                      const bf16_t* Bt = isq ? (const bf16_t*)(p.ws + WS_WTQUP) + (size_t)l * 384 * 256 : (const bf16_t*)(p.ws + WS_WTKV) + (size_t)l * 512 * 128;
                      const int K = isq ? 256 : 128, row0 = (isq ? u / 3 : v / 4) * 256, col0 = (isq ? u % 3 : v % 4) * 128;
                      gemm_prefetch(A, Bt, K, row0, col0, lds);
                      gemm_tile(A, Bt, K, row0, col0, lds, acc);
                      if (isq) epi_qup(p, acc, u / 3, u % 3); else epi_kvup(p, acc, v / 4, v % 4); } }
                if (multi) { FRESH_PARAMS(pb); xcd_arrive2((unsigned*)(pb.ws + WS_BAR), xcc, bst, 1); }
                if (multi) { FRESH_PARAMS(pb); xcd_wait2((unsigned*)(pb.ws + WS_BAR), bst, l == 0 ? 1u : 3u, 0); }
                { const bool mlab = bid >= 128; const int bb = bid & 127;
                  for (int i = 0; i < 4; ++i) {
                      const int u = mlab ? (i == 0 ? 256 + bb : i == 1 ? 1152 + bb : i == 2 ? 128 + bb : 896 + bb) : (i == 0 ? bb : i == 1 ? 384 + bb : i == 2 ? 640 + bb : N_MIX_UNITS);
                      if (mlab && i == 2 && multi) { FRESH_PARAMS(pb); xcd_wait2((unsigned*)(pb.ws + WS_BAR), bst, (unsigned)l + 1u, 1); }
                      if (u < N_MIX_UNITS) { FRESH_PARAMS(p); mixer_unit(p, l, u, lds); } } }
            } else if (sub == 3) {
                { FRESH_PARAMS(p); const int tm = grp, tn = mem; f32x4 acc[4][4];
                    const bf16_t* A = (const bf16_t*)(p.ws + WS_MIX); const bf16_t* Bt = (const bf16_t*)(p.ws + WS_WTOUT) + (size_t)l * 1024 * 1024;
                    gemm_prefetch(A, Bt, 1024, tm * 256, tn * 128, lds);
                    ResidPrep rp; resid_prep(rp, p, tm, tn, l == 0);
                    gemm_tile(A, Bt, 1024, tm * 256, tn * 128, lds, acc);
                    epi_resid(p, l, acc, tm, tn, 2, l == 0, p.in[I_GFF] + l * 1024, l, 4, WS_SSQ2, rp); }
            } else if (sub == 4) {
                const bf16_t* A = (const bf16_t*)(p_.ws + WS_H); const bf16_t* Bt = (const bf16_t*)(p_.ws + WS_WTFF1) + (size_t)l * 4096 * 1024;
                FoldPrep fc; const int tm = grp; int tn = mem;
                if (multi) { FRESH_PARAMS(pb); xcd_wait2((unsigned*)(pb.ws + WS_BAR), bst, (unsigned)l, 2); }
                { FRESH_PARAMS(p);
                  gemm_prefetch(A, Bt, 1024, tm * 256, tn * 128, lds);
                  fold_prep(fc, (const float*)(p.ws + WS_BIAS2) + ((size_t)l * 3 + seg_of_row(tm * 256)) * 4096, (const float*)(p.ws + WS_SSQ2), tm, tn, true); }
                for (int r = 0; r < 4; ++r) { FRESH_PARAMS(p); f32x4 acc[4][4];
                    gemm_tile(A, Bt, 1024, tm * 256, tn * 128, lds, acc);
                    const bool nx = r < 3; const int tn2 = tn + 8;
                    if (nx) gemm_prefetch(A, Bt, 1024, tm * 256, tn2 * 128, lds);
                    epi_ff1(p, acc, tm, tn, fc);
                    if (nx) fold_prep(fc, (const float*)(p.ws + WS_BIAS2) + ((size_t)l * 3 + seg_of_row(tm * 256)) * 4096, (const float*)(p.ws + WS_SSQ2), tm, tn2, true);
                    tn = tn2; }
            } else {
                { FRESH_PARAMS(p); const int tm = grp, tn = mem; f32x4 acc[4][4];
                    const bool more = l + 1 < NLAYER;
                    const bf16_t* A = (const bf16_t*)(p.ws + WS_HBUF); const bf16_t* Bt = (const bf16_t*)(p.ws + WS_WTFF2) + (size_t)l * 1024 * 4096;
                    gemm_prefetch(A, Bt, 4096, tm * 256, tn * 128, lds);
                    ResidPrep rp; resid_prep(rp, p, tm, tn, false);
                    gemm_tile(A, Bt, 4096, tm * 256, tn * 128, lds, acc);
                    epi_resid(p, l, acc, tm, tn, 5, false, more ? p.in[I_GMIX] + (l + 1) * 1024 : nullptr, more ? l + 1 : l, 1, WS_SSQ1, rp, !more);
                    if (!more && multi) {
                        { FRESH_PARAMS(pb); grp_barrier((unsigned*)(pb.ws + WS_BAR), grp, mem, gep, glocal); ++gep; }
                        FRESH_PARAMS(pf); final_from_regs(pf, acc, tm, tn); } }
            }
        }
        if (multi && ph + 1 < ph_hi) {
            const int sb = ph == 0 ? 0 : (ph - 1) % 5;
            FRESH_PARAMS(pb);
            if (ph == 0 || sb != 1) { grp_barrier((unsigned*)(pb.ws + WS_BAR), grp, mem, gep, glocal); ++gep;
                if (ph > 0 && sb == 0) xcd_arrive2((unsigned*)(pb.ws + WS_BAR), xcc, bst, 0); }
            else {
                const int lm = (ph - 1) / 5;
                xcd_arrive2((unsigned*)(pb.ws + WS_BAR), xcc, bst, 0);
                { FRESH_PARAMS(p); transpose_one(p, 748 * lm + 492 + opaque_bid(), lds); }
                { const int ob = opaque_bid();
                  if (ob >= 128) { FRESH_PARAMS(p); bias_unit(p, (lm == 0 ? 80 : 208) + (ob - 128)); }
                  else if (lm == 0 && ob < 80) { FRESH_PARAMS(p); bias_unit(p, ob); } }
                xcd_arrive2((unsigned*)(pb.ws + WS_BAR), xcc, bst, 2);
                xcd_wait2((unsigned*)(pb.ws + WS_BAR), bst, lm == 0 ? 2u : 4u, 0);
            }
        }
    }
}

extern "C" void kernel_launch(void* const* d_in, const int* in_sizes, int n_in, void* d_out, int out_size, void* d_ws, size_t ws_size, hipStream_t stream) {
    static int grid = 0;
    if (grid == 0) {
        if (n_in != N_IN || ws_size < WS_END) { fprintf(stderr, "kernel_launch: unexpected n_in %d / ws_size %zu (need %zu)\n", n_in, ws_size, (size_t)WS_END); grid = -1; return; }
        if (hipFuncSetAttribute((const void*)mk_fwd, hipFuncAttributeMaxDynamicSharedMemorySize, LDS_BYTES) != hipSuccess) { fprintf(stderr, "kernel_launch: hipFuncSetAttribute failed\n"); grid = -1; return; }
        int dev = 0, cus = 0, per_cu = 0;
        (void)hipGetDevice(&dev); (void)hipDeviceGetAttribute(&cus, hipDeviceAttributeMultiprocessorCount, dev);
        if (hipOccupancyMaxActiveBlocksPerMultiprocessor(&per_cu, (const void*)mk_fwd, NT, LDS_BYTES) != hipSuccess || per_cu < 1) per_cu = 1;
        grid = cus;
        if (cus != 256) { fprintf(stderr, "kernel_launch: built for a 256-CU device (one 256x128 ff2 tile per workgroup); found %d CUs; nothing launched\n", cus); grid = -1; return; }
        fprintf(stderr, "kernel_launch: %d CUs, occupancy query %d, grid %d\n", cus, per_cu, grid);
    }
    if (grid < 0) return;
    Params p{};
    for (int i = 0; i < N_IN; ++i) p.in[i] = (const float*)d_in[i];
    p.out = (float*)d_out; p.ws = (unsigned char*)d_ws;
    (void)hipMemsetAsync((unsigned char*)d_ws + WS_BAR, 0, 32768, stream);
    int lo = 0, hi = N_PHASES;
    void* args[] = {&p, &lo, &hi};
    hipError_t e = hipLaunchCooperativeKernel((const void*)mk_fwd, dim3(grid), dim3(NT), args, LDS_BYTES, stream);
    if (e != hipSuccess) fprintf(stderr, "cooperative launch failed: %s (grid %d)\n", hipGetErrorString(e), grid);
}
```
